# Optimizing an MI355X kernel written in HIP

```python
import math
import jax
import jax.numpy as jnp
from jax import lax
import numpy as np

D_MODEL = 1024
BATCH = 1
SEQ = 16384
DEPTH = 2

CTX_LEN = 256
GRID_W = 64
BRANCH_W = 256
N_BRANCH = 4
CONF_K = 31
SCONV_K = 3
DIFF_HEADS = 4
DIFF_DK = 32
DIFF_DV = 2 * DIFF_DK
RET_HEADS = 4
RET_DK = 32
RET_DV = 2 * RET_DK
RET_CHUNK = 128
Q_BLOCK = 128
ROPE_BASE = 10000.0
N_EXPERTS = 16
N_GROUPS = 4
EXPERTS_PER_GROUP = N_EXPERTS // N_GROUPS
TOP_K = 2
D_FF_EXPERT = 512
MOE_BLOCK = 256
EPS = 1e-6
IN_SPLITS = (2 * BRANCH_W,
             3 * BRANCH_W,
             DIFF_HEADS * 2 * DIFF_DK,
             DIFF_HEADS * 2 * DIFF_DK,
             DIFF_HEADS * DIFF_DV,
             RET_HEADS * RET_DK,
             RET_HEADS * RET_DK,
             RET_HEADS * RET_DV,
             BRANCH_W)
IN_COLS = sum(IN_SPLITS)

kernel_name = 'hybrid_gated_branch_dit_moe'


def rms_norm(x, g):
    xf = x.astype(jnp.float32)
    y = xf * lax.rsqrt(jnp.mean(xf * xf, axis=-1, keepdims=True) + EPS)
    return (y * g.astype(jnp.float32)).astype(x.dtype)


def layer_norm(x, g=None, b=None):
    xf = x.astype(jnp.float32)
    mu = jnp.mean(xf, axis=-1, keepdims=True)
    var = jnp.mean(jnp.square(xf - mu), axis=-1, keepdims=True)
    y = (xf - mu) * lax.rsqrt(var + EPS)
    if g is not None:
        y = y * g.astype(jnp.float32) + b.astype(jnp.float32)
    return y.astype(x.dtype)


def adaln(cv, w, b):
    return jnp.split(jax.nn.silu(cv) @ w + b, 6, axis=-1)


def modulate(h, shift, scale):
    return h * (1.0 + scale) + shift


def split_cols(z):
    points = np.cumsum(np.array(IN_SPLITS))[:-1].tolist()
    return jnp.split(z, points, axis=-1)


def axial_rope(length, dim):
    rows = length // GRID_W
    row = jnp.repeat(jnp.arange(rows, dtype=jnp.float32), GRID_W)
    col = jnp.tile(jnp.arange(GRID_W, dtype=jnp.float32), rows)
    nf = dim // 4
    inv = ROPE_BASE ** (-jnp.arange(nf, dtype=jnp.float32) / nf)
    ang = jnp.concatenate([row[:, None] * inv, col[:, None] * inv], axis=-1)
    return jnp.cos(ang), jnp.sin(ang)


def apply_rope(x, cos, sin):
    x1, x2 = jnp.split(x.astype(jnp.float32), 2, axis=-1)
    c = cos[None, :, None, :]
    s = sin[None, :, None, :]
    return jnp.concatenate([x1 * c - x2 * s, x1 * s + x2 * c], axis=-1).astype(x.dtype)


def depthwise_conv(x, w):
    k = w.shape[0]
    pad = (k - 1) // 2
    return lax.conv_general_dilated(x, w[:, None, :].astype(x.dtype), window_strides=(1,),
                                    padding=[(pad, pad)], dimension_numbers=('NWC', 'WIO', 'NWC'),
                                    feature_group_count=x.shape[-1])


def conformer_conv(z, w_dw, b_dw, g_n, b_n):
    a, gt = jnp.split(z, 2, axis=-1)
    u = a * jax.nn.sigmoid(gt)
    u = depthwise_conv(u, w_dw) + b_dw
    return jax.nn.silu(layer_norm(u, g_n, b_n))


def short_conv(z, w_dw):
    bg, cg, xv = jnp.split(z, 3, axis=-1)
    return bg * depthwise_conv(cg * xv, w_dw)


def split_maps(z, rope):
    b, l, _ = z.shape
    z = z.reshape(b, l, DIFF_HEADS, 2, DIFF_DK)
    z1, z2 = z[..., 0, :], z[..., 1, :]
    if rope is not None:
        z1 = apply_rope(z1, *rope)
        z2 = apply_rope(z2, *rope)
    return z1, z2


def two_map_attention(q1, q2, k1, k2, v, lam):
    scale = DIFF_DK ** -0.5
    s1 = jnp.einsum('bqhd,bkhd->bhqk', q1, k1).astype(jnp.float32) * scale
    s2 = jnp.einsum('bqhd,bkhd->bhqk', q2, k2).astype(jnp.float32) * scale
    a = jax.nn.softmax(s1, axis=-1) - lam * jax.nn.softmax(s2, axis=-1)
    return jnp.einsum('bhqk,bkhe->bqhe', a.astype(v.dtype), v)


def diff_attention_latent(q1, q2, k1, k2, v, lam):
    b, l, h, dk = q1.shape
    nb = l // Q_BLOCK
    qb1 = jnp.moveaxis(q1.reshape(b, nb, Q_BLOCK, h, dk), 1, 0)
    qb2 = jnp.moveaxis(q2.reshape(b, nb, Q_BLOCK, h, dk), 1, 0)
    o = lax.map(lambda qs: two_map_attention(qs[0], qs[1], k1, k2, v, lam), (qb1, qb2))
    return jnp.moveaxis(o, 0, 1).reshape(b, l, h, DIFF_DV)


def diff_lambda(lq1, lk1, lq2, lk2, lam_init):
    f = jnp.float32
    return (jnp.exp(jnp.sum(lq1.astype(f) * lk1.astype(f))) -
            jnp.exp(jnp.sum(lq2.astype(f) * lk2.astype(f))) + lam_init)


def diff_out(o, g, lam_init):
    b, l = o.shape[:2]
    return (rms_norm(o, g) * (1.0 - lam_init)).reshape(b, l, DIFF_HEADS * DIFF_DV)


def retention_chunked(q, k, v, log_gamma, s0):
    f = jnp.float32
    b, l, h, dk = q.shape
    dv = v.shape[-1]
    n = l // RET_CHUNK
    qc = q.reshape(b, n, RET_CHUNK, h, dk)
    kc = k.reshape(b, n, RET_CHUNK, h, dk)
    vc = v.reshape(b, n, RET_CHUNK, h, dv)
    lg = log_gamma.astype(f)
    pos = jnp.arange(RET_CHUNK, dtype=f)
    diff = pos[:, None] - pos[None, :]
    dmask = jnp.exp(jnp.where(diff[None] >= 0, diff[None] * lg[:, None, None], -jnp.inf))
    scores = jnp.einsum('bnihd,bnjhd->bnhij', qc, kc).astype(f) * dmask
    o_intra = jnp.einsum('bnhij,bnjhe->bnihe', scores, vc.astype(f))
    q_dec = jnp.exp((pos + 1.0)[:, None] * lg[None, :])
    k_dec = jnp.exp((RET_CHUNK - 1.0 - pos)[:, None] * lg[None, :])
    kv = jnp.einsum('bnjhd,bnjhe->bnhde', kc.astype(f) * k_dec[:, :, None], vc.astype(f))
    chunk_dec = jnp.exp(RET_CHUNK * lg)[None, :, None, None]

    def step(s, kv_n):
        return chunk_dec * s + kv_n, s

    s_final, s_start = lax.scan(step, s0.astype(f), jnp.moveaxis(kv, 1, 0))
    o_cross = jnp.einsum('bnihd,nbhde->bnihe', qc.astype(f) * q_dec[:, :, None], s_start)
    o = (o_intra + o_cross).reshape(b, l, h, dv)
    return o.astype(v.dtype), s_final


def bidir_retention(q, k, v, ld_f, ld_b, s0_f, s0_b):
    o_f, s_f = retention_chunked(q, k, v, ld_f, s0_f)
    o_b, s_b = retention_chunked(jnp.flip(q, 1), jnp.flip(k, 1), jnp.flip(v, 1), ld_b, s0_b)
    return o_f + jnp.flip(o_b, 1), s_f, s_b


def ret_qkv(z, rope):
    b, l, _ = z[5].shape
    q = z[5].reshape(b, l, RET_HEADS, RET_DK)
    k = z[6].reshape(b, l, RET_HEADS, RET_DK) * (RET_DK ** -0.5)
    v = z[7].reshape(b, l, RET_HEADS, RET_DV)
    if rope is not None:
        q = apply_rope(q, *rope)
        k = apply_rope(k, *rope)
    return q, k, v


def retention_out(o, g):
    b, l = o.shape[:2]
    return jax.nn.silu(g) * layer_norm(o).reshape(b, l, RET_HEADS * RET_DV)


def merge_branches(h, ys, w_gate, b_gate, w_branch, w_o):
    gates = jax.nn.sigmoid((h @ w_gate + b_gate).astype(jnp.float32)).astype(h.dtype)
    gates = gates.reshape(h.shape[:-1] + (N_BRANCH, D_MODEL))
    m = gates[..., 0, :] * (ys[0] @ w_branch[0])
    for i in range(1, N_BRANCH):
        m = m + gates[..., i, :] * (ys[i] @ w_branch[i])
    return m @ w_o


def token_mixers(hl, hc, p, lam_init, last):
    b, l, _ = hl.shape
    zl = split_cols(hl @ p['w_in'])
    zc = split_cols(hc @ p['w_in'])
    rope = axial_rope(l, DIFF_DK)
    lam = diff_lambda(p['lam_q1'], p['lam_k1'], p['lam_q2'], p['lam_k2'], lam_init)
    kc1, kc2 = split_maps(zc[3], None)
    vc = zc[4].reshape(b, -1, DIFF_HEADS, DIFF_DV)
    q1, q2 = split_maps(zl[2], rope)
    k1, k2 = split_maps(zl[3], rope)
    vl = zl[4].reshape(b, l, DIFF_HEADS, DIFF_DV)
    o_attn = diff_attention_latent(q1, q2, jnp.concatenate([kc1, k1], 1), jnp.concatenate([kc2, k2], 1),
                                   jnp.concatenate([vc, vl], 1), lam)
    qrc, krc, vrc = ret_qkv(zc, None)
    qrl, krl, vrl = ret_qkv(zl, rope)
    s0 = jnp.zeros((b, RET_HEADS, RET_DK, RET_DV), jnp.float32)
    orc, s_f, s_b = bidir_retention(qrc, krc, vrc, p['ret_ld_f'], p['ret_ld_b'], s0, s0)
    orl, _, _ = bidir_retention(qrl, krl, vrl, p['ret_ld_f'], p['ret_ld_b'], s_f, s_b)
    ys_l = [conformer_conv(zl[0], p['conv_a_w'], p['conv_a_b'], p['conv_a_g'], p['conv_a_beta']),
            short_conv(zl[1], p['conv_b_w']),
            diff_out(o_attn, p['diff_g'], lam_init),
            retention_out(orl, zl[8])]
    yl = merge_branches(hl, ys_l, p['w_gate'], p['b_gate'], p['w_branch'], p['w_o'])
    if last:
        return yl, None
    qc1, qc2 = split_maps(zc[2], None)
    ys_c = [conformer_conv(zc[0], p['conv_a_w'], p['conv_a_b'], p['conv_a_g'], p['conv_a_beta']),
            short_conv(zc[1], p['conv_b_w']),
            diff_out(two_map_attention(qc1, qc2, kc1, kc2, vc, lam), p['diff_g'], lam_init),
            retention_out(orc, zc[8])]
    yc = merge_branches(hc, ys_c, p['w_gate'], p['b_gate'], p['w_branch'], p['w_o'])
    return yl, yc


def grouped_moe(h, w_router, b_router, w1, w3, w2):
    f = jnp.float32
    t = h.shape[0]
    s = jax.nn.sigmoid((h @ w_router).astype(f))
    sb = s + b_router.astype(f)
    gscore = lax.top_k(sb.reshape(t, N_GROUPS, EXPERTS_PER_GROUP), 2)[0].sum(-1)
    gsel = jnp.argmax(gscore, axis=-1)
    egroup = jnp.arange(N_EXPERTS) // EXPERTS_PER_GROUP
    sb_m = jnp.where(egroup[None, :] == gsel[:, None], sb, -jnp.inf)
    _, eidx = lax.top_k(sb_m, TOP_K)
    wsel = jnp.take_along_axis(s, eidx, axis=-1)
    wsel = wsel / jnp.sum(wsel, axis=-1, keepdims=True)
    a = t * TOP_K
    e_flat = eidx.reshape(a)
    w_flat = wsel.reshape(a)
    tok_flat = jnp.repeat(jnp.arange(t, dtype=jnp.int32), TOP_K)
    order = jnp.argsort(e_flat)
    e_sorted = e_flat[order]
    counts = jnp.bincount(e_flat, length=N_EXPERTS)
    start = jnp.cumsum(counts) - counts
    padded = (counts + MOE_BLOCK - 1) // MOE_BLOCK * MOE_BLOCK
    pend = jnp.cumsum(padded)
    pstart = pend - padded
    pos = pstart[e_sorted] + jnp.arange(a) - start[e_sorted]
    cap = (a + N_EXPERTS * MOE_BLOCK + MOE_BLOCK - 1) // MOE_BLOCK * MOE_BLOCK
    nb = cap // MOE_BLOCK
    buf_tok = jnp.zeros((cap,), jnp.int32).at[pos].set(tok_flat[order])
    buf_w = jnp.zeros((cap,), f).at[pos].set(w_flat[order])
    blk_e = jnp.minimum(jnp.searchsorted(pend, jnp.arange(nb) * MOE_BLOCK, side='right'), N_EXPERTS - 1)

    def expert_block(args):
        idx, wt, e = args
        xb = h[idx]
        u = jax.nn.silu(xb @ w1[e]) * (xb @ w3[e])
        return (u @ w2[e]) * wt[:, None].astype(h.dtype)

    y = lax.map(expert_block, (buf_tok.reshape(nb, MOE_BLOCK), buf_w.reshape(nb, MOE_BLOCK), blk_e))
    return jnp.zeros_like(h).at[buf_tok].add(y.reshape(cap, D_MODEL))


def setup_inputs(seed: int = 0) -> dict:
    key = jax.random.key(seed)
    ks = jax.random.split(key, 40)
    D = D_MODEL

    def nrm(k, shape, scale):
        return jax.random.normal(k, shape, jnp.float32) * scale

    base_ld = jnp.log(1.0 - 2.0 ** (-5.0 - jnp.arange(RET_HEADS, dtype=jnp.float32)))
    return {
        'x': nrm(ks[0], (BATCH, SEQ, D), 1.0),
        'c': nrm(ks[1], (BATCH, D), 1.0),
        'ctx': nrm(ks[2], (BATCH, CTX_LEN, D), 1.0),
        'c_ctx': nrm(ks[3], (D,), 1.0),
        'w_mod': nrm(ks[4], (DEPTH, D, 6 * D), 0.3 * D ** -0.5),
        'b_mod': nrm(ks[5], (DEPTH, 6 * D), 0.02),
        'g_norm1': 1.0 + nrm(ks[6], (DEPTH, D), 0.02),
        'g_norm2': 1.0 + nrm(ks[7], (DEPTH, D), 0.02),
        'w_in': nrm(ks[8], (DEPTH, D, IN_COLS), D ** -0.5),
        'conv_a_w': nrm(ks[9], (DEPTH, CONF_K, BRANCH_W), CONF_K ** -0.5),
        'conv_a_b': nrm(ks[10], (DEPTH, BRANCH_W), 0.02),
        'conv_a_g': 1.0 + nrm(ks[11], (DEPTH, BRANCH_W), 0.02),
        'conv_a_beta': nrm(ks[12], (DEPTH, BRANCH_W), 0.02),
        'conv_b_w': nrm(ks[13], (DEPTH, SCONV_K, BRANCH_W), SCONV_K ** -0.5),
        'lam_q1': nrm(ks[14], (DEPTH, DIFF_DK), 0.1),
        'lam_k1': nrm(ks[15], (DEPTH, DIFF_DK), 0.1),
        'lam_q2': nrm(ks[16], (DEPTH, DIFF_DK), 0.1),
        'lam_k2': nrm(ks[17], (DEPTH, DIFF_DK), 0.1),
        'diff_g': 1.0 + nrm(ks[18], (DEPTH, DIFF_DV), 0.02),
        'ret_ld_f': base_ld[None, :] * (1.0 + nrm(ks[19], (DEPTH, RET_HEADS), 0.1)),
        'ret_ld_b': base_ld[None, :] * (1.0 + nrm(ks[20], (DEPTH, RET_HEADS), 0.1)),
        'w_gate': nrm(ks[21], (DEPTH, D, N_BRANCH * D), D ** -0.5),
        'b_gate': nrm(ks[22], (DEPTH, N_BRANCH * D), 0.02),
        'w_branch': nrm(ks[23], (DEPTH, N_BRANCH, BRANCH_W, D), BRANCH_W ** -0.5),
        'w_o': nrm(ks[24], (DEPTH, D, D), D ** -0.5),
        'w_router': nrm(ks[25], (D, N_EXPERTS), D ** -0.5),
        'b_router': nrm(ks[26], (N_EXPERTS,), 0.01),
        'w1_e': nrm(ks[27], (DEPTH, N_EXPERTS, D, D_FF_EXPERT), D ** -0.5),
        'w3_e': nrm(ks[28], (DEPTH, N_EXPERTS, D, D_FF_EXPERT), D ** -0.5),
        'w2_e': nrm(ks[29], (DEPTH, N_EXPERTS, D_FF_EXPERT, D), D_FF_EXPERT ** -0.5),
        'g_final': 1.0 + nrm(ks[30], (D,), 0.02),
    }


def reference(x, c, ctx, c_ctx, w_mod, b_mod, g_norm1, g_norm2, w_in, conv_a_w, conv_a_b, conv_a_g,
              conv_a_beta, conv_b_w, lam_q1, lam_k1, lam_q2, lam_k2, diff_g, ret_ld_f, ret_ld_b,
              w_gate, b_gate, w_branch, w_o, w_router, b_router, w1_e, w3_e, w2_e, g_final):
    xl, xc = x, ctx
    for l in range(DEPTH):
        last = l == DEPTH - 1
        lam_init = 0.8 - 0.6 * math.exp(-0.3 * l)
        p = {'w_in': w_in[l], 'conv_a_w': conv_a_w[l], 'conv_a_b': conv_a_b[l], 'conv_a_g': conv_a_g[l],
             'conv_a_beta': conv_a_beta[l], 'conv_b_w': conv_b_w[l], 'lam_q1': lam_q1[l], 'lam_k1': lam_k1[l],
             'lam_q2': lam_q2[l], 'lam_k2': lam_k2[l], 'diff_g': diff_g[l], 'ret_ld_f': ret_ld_f[l],
             'ret_ld_b': ret_ld_b[l], 'w_gate': w_gate[l], 'b_gate': b_gate[l], 'w_branch': w_branch[l],
             'w_o': w_o[l]}
        mod_l = [m[:, None, :] for m in adaln(c, w_mod[l], b_mod[l])]
        mod_c = adaln(c_ctx, w_mod[l], b_mod[l])
        hl = modulate(rms_norm(xl, g_norm1[l]), mod_l[0], mod_l[1])
        hc = modulate(rms_norm(xc, g_norm1[l]), mod_c[0], mod_c[1])
        yl, yc = token_mixers(hl, hc, p, lam_init, last)
        xl = xl + mod_l[2] * yl
        hl2 = modulate(rms_norm(xl, g_norm2[l]), mod_l[3], mod_l[4])
        n_lat = hl2.shape[0] * hl2.shape[1]
        if last:
            ml = grouped_moe(hl2.reshape(n_lat, D_MODEL), w_router, b_router, w1_e[l], w3_e[l], w2_e[l])
            xl = xl + mod_l[5] * ml.reshape(xl.shape)
        else:
            xc = xc + mod_c[2] * yc
            hc2 = modulate(rms_norm(xc, g_norm2[l]), mod_c[3], mod_c[4])
            tokens = jnp.concatenate([hl2.reshape(n_lat, D_MODEL), hc2.reshape(-1, D_MODEL)], axis=0)
            m = grouped_moe(tokens, w_router, b_router, w1_e[l], w3_e[l], w2_e[l])
            xl = xl + mod_l[5] * m[:n_lat].reshape(xl.shape)
            xc = xc + mod_c[5] * m[n_lat:].reshape(xc.shape)
    return rms_norm(xl, g_final)
```

```cpp
#include <hip/hip_runtime.h>
#include <hip/hip_cooperative_groups.h>
#include <cstdio>
#include <cstdint>
namespace cg = cooperative_groups;

#ifndef DUP_KIND
#define DUP_KIND -1
#endif
#ifndef MK_ONE_LAUNCH
#define MK_ONE_LAUNCH 1
#endif
#ifndef MK_NAIVE_ATTN
#define MK_NAIVE_ATTN 0
#endif
#ifndef MK_NAIVE_RET
#define MK_NAIVE_RET 0
#endif

#define LAS __attribute__((address_space(3)))
typedef unsigned short bf16_t;
typedef short bf16x8 __attribute__((ext_vector_type(8)));
typedef float f32x4 __attribute__((ext_vector_type(4)));
typedef float f32x2 __attribute__((ext_vector_type(2)));
typedef float f32x16 __attribute__((ext_vector_type(16)));
typedef unsigned u32x4 __attribute__((ext_vector_type(4)));
typedef unsigned u32x2 __attribute__((ext_vector_type(2)));
typedef __bf16 bf16x2_t __attribute__((ext_vector_type(2)));

constexpr int D = 1024, SEQ = 16384, CTXL = 256, MT = SEQ + CTXL;
constexpr int ZLD = 2816, GLD = 4096, NIN = ZLD + GLD;
constexpr int ZC_CONF = 0, ZC_SC = 512, ZC_DQ = 1280, ZC_DK = 1536, ZC_DV = 1792, ZC_RQ = 2048, ZC_RK = 2176, ZC_RV = 2304, ZC_RG = 2560;
constexpr int NE = 16, FFE = 512, CAP = 37376, NCH = MT / 128;
constexpr float EPS = 1e-6f;
constexpr float QSCALE = 0.17677669529663687f * 1.4426950408889634f;
constexpr float RKSCALE = 0.17677669529663687f;
constexpr int NTHR = 512, NWAVES = 8;

constexpr size_t MiB = 1u << 20;
constexpr size_t WS_CTL = 0, CTL_ZERO_BYTES = 256 * 1024;
constexpr size_t WS_MODV = 1 * MiB;
constexpr size_t WS_ROPE = WS_MODV + 128 * 1024;
constexpr size_t WS_META = WS_ROPE + 32 * 1024;
constexpr size_t WS_INV = WS_META + 64 * 1024;
constexpr size_t WS_XC = 2 * MiB;
constexpr size_t WS_ROUTE = 3 * MiB;
constexpr size_t WS_WIN = 4 * MiB;
constexpr size_t WS_WB = WS_WIN + (size_t)NIN * D * 2;
constexpr size_t WS_WO = WS_WB + 2 * MiB;
constexpr size_t WS_W13 = WS_WO + 2 * MiB;
constexpr size_t WS_W2 = WS_W13 + 32 * MiB;
constexpr size_t WS_H = 70 * MiB;
constexpr size_t WS_Z = 103 * MiB;
constexpr size_t WS_G = 193 * MiB;
constexpr size_t WS_Y = 323 * MiB;
constexpr size_t WS_MODP = WS_Y;
constexpr size_t WS_KV = 356 * MiB;
constexpr size_t WS_SST = WS_KV + 8 * MiB + 512 * 1024;
constexpr size_t WS_END = 369 * MiB;
static_assert(WS_W2 + 16 * MiB <= WS_H && WS_H + (size_t)MT * D * 2 <= WS_Z && WS_Z + (size_t)MT * ZLD * 2 <= WS_G && WS_G + (size_t)MT * GLD * 2 <= WS_Y, "ws map");
static_assert(WS_Y + (size_t)MT * D * 2 <= WS_KV && (size_t)2 * NCH * 4 * 2048 * 4 <= 8 * MiB + 512 * 1024 && WS_SST + (size_t)2 * NCH * 4 * 2048 * 2 <= WS_END, "ws map 2");
static_assert((size_t)CAP * D * 2 <= (size_t)MT * ZLD * 2 && (size_t)CAP * D * 2 + (size_t)CAP * FFE * 2 <= (size_t)MT * GLD * 2, "moe alias");
constexpr int CW_CNT = 0;
constexpr int CW_BAR = 8192;
constexpr int CW_MDONE = 53248;
constexpr int CW_E1DONE = 32768;
constexpr int CW_SCAN = 28672;
constexpr int CW_KMAXG = 24576;
constexpr int CW_KMAX = 16384;

__device__ __forceinline__ unsigned cvtpk(float lo, float hi) { f32x2 v = {lo, hi}; bf16x2_t b = __builtin_convertvector(v, bf16x2_t); return __builtin_bit_cast(unsigned, b); }
__device__ __forceinline__ float bflo(unsigned u) { return __uint_as_float(u << 16); }
__device__ __forceinline__ float bfhi(unsigned u) { return __uint_as_float(u & 0xffff0000u); }
__device__ __forceinline__ float bf2f(bf16_t h) { return __uint_as_float(((unsigned)h) << 16); }
__device__ __forceinline__ bf16_t f2bf(float f) { return (bf16_t)(cvtpk(f, 0.f) & 0xffffu); }
template <int CTRL> __device__ __forceinline__ float dpp_f(float v) { return __int_as_float(__builtin_amdgcn_update_dpp(0, __float_as_int(v), CTRL, 0xf, 0xf, true)); }
__device__ __forceinline__ float xor1_f(float v) { return dpp_f<0xB1>(v); }
__device__ __forceinline__ float swap32_other(float v, int lane) {
    auto rr = __builtin_amdgcn_permlane32_swap(__float_as_uint(v), __float_as_uint(v), false, false);
    return __uint_as_float(lane < 32 ? rr[1] : rr[0]);
}
__device__ __forceinline__ float wave_sum(float v) {
    v += dpp_f<0xB1>(v); v += dpp_f<0x4E>(v); v += dpp_f<0x141>(v); v += dpp_f<0x140>(v);
    { auto rr = __builtin_amdgcn_permlane16_swap(__float_as_uint(v), __float_as_uint(v), false, false); v = __uint_as_float(rr[0]) + __uint_as_float(rr[1]); }
    { auto rr = __builtin_amdgcn_permlane32_swap(__float_as_uint(v), __float_as_uint(v), false, false); v = __uint_as_float(rr[0]) + __uint_as_float(rr[1]); }
    return v;
}
__device__ __forceinline__ float wave_max(float v) {
    v = fmaxf(v, dpp_f<0xB1>(v)); v = fmaxf(v, dpp_f<0x4E>(v)); v = fmaxf(v, dpp_f<0x141>(v)); v = fmaxf(v, dpp_f<0x140>(v));
    { auto rr = __builtin_amdgcn_permlane16_swap(__float_as_uint(v), __float_as_uint(v), false, false); v = fmaxf(__uint_as_float(rr[0]), __uint_as_float(rr[1])); }
    { auto rr = __builtin_amdgcn_permlane32_swap(__float_as_uint(v), __float_as_uint(v), false, false); v = fmaxf(__uint_as_float(rr[0]), __uint_as_float(rr[1])); }
    return v;
}
__device__ __forceinline__ float sigmoidf_(float x) { return __builtin_amdgcn_rcpf(1.f + __expf(-x)); }
__device__ __forceinline__ float siluf_(float x) { return x * sigmoidf_(x); }
#define LDS_WAIT() asm volatile("s_waitcnt lgkmcnt(0)" ::: "memory")
template <class V> __device__ __forceinline__ void st16_wt(void* p, const V& v) { asm volatile("global_store_dwordx4 %0, %1, off sc1\n\ts_nop 1" :: "v"(p), "v"(v) : "memory"); }

namespace pg8 {
constexpr int BM = 256, BK = 64, HALF = 128, HTB = HALF * BK * 2, STAGE_BYTES = 8 * HTB, NXCD = 8, WGM = 8;
__device__ __forceinline__ int lds_byte(int r, int c) { return r * 128 + ((((c >> 3) ^ (r >> 1)) & 7) * 16) + (c & 7) * 2; }
__device__ __forceinline__ void stage_rc(int b, int& R, int& C) { R = b >> 7; C = ((((b >> 4) ^ (R >> 1)) & 7) * 8); }
__device__ __forceinline__ int perm32(int rho) { const int n = rho >> 4, i = rho & 15; return 8 * (i >> 2) + 4 * n + (i & 3); }

struct Unit { int pm, pn, aux; unsigned aoff, boff; };
struct Gemm { const bf16_t* A; const bf16_t* Bt; int lda, ldb, K; };

__device__ __forceinline__ bool dense_tile(long L, int nM, int nN, int& pm, int& pn) {
    const int nwg = nM * nN; if (L >= nwg) return false;
    int wgid = (int)L; { const int q = nwg / NXCD, r = nwg % NXCD, xcd = wgid % NXCD, off = wgid / NXCD; wgid = (xcd < r ? xcd * (q + 1) : r * (q + 1) + (xcd - r) * q) + off; }
    const int nig = WGM * nN, gid = wgid / nig, fm = gid * WGM, gsz = (nM - fm) < WGM ? (nM - fm) : WGM;
    pm = fm + ((wgid % nig) % gsz); pn = (wgid % nig) / gsz; return true;
}
struct DenseOrder {
    static constexpr bool GATHER = false;
    __device__ __forceinline__ void a_ready(const Unit&, int) const {}
    __device__ __forceinline__ void done(const Unit&, int) const {}
    int nM, nN, G, c, lda, ldb;
    __device__ __forceinline__ bool next(int i, Unit& u) const {
        if (!dense_tile((long)i * G + c, nM, nN, u.pm, u.pn)) return false;
        u.aux = 0; u.aoff = (unsigned)(u.pm * BM * lda * 2); u.boff = (unsigned)(u.pn * BM * ldb * 2); return true;
    }
};
struct WoOrder {
    static constexpr bool GATHER = false;
    int nM, G, c; unsigned* done_cnt;
    __device__ __forceinline__ bool next(int i, Unit& u) const {
        const int rw = (nM * 4) % G, cr = (c + rw) % G;
        if (!dense_tile((long)i * G + cr, nM, 4, u.pm, u.pn)) return false;
        u.aux = 0; u.aoff = (unsigned)(u.pm * BM * D * 2); u.boff = (unsigned)(u.pn * BM * D * 2); return true;
    }
    __device__ __forceinline__ void done(const Unit&, int) const {}
    __device__ __forceinline__ void a_ready(const Unit& u, int tid) const {
        if (tid < 64) { unsigned sp = 0;
            while ((unsigned)__builtin_amdgcn_readfirstlane(__hip_atomic_load(done_cnt + 64 * u.pm, __ATOMIC_RELAXED, __HIP_MEMORY_SCOPE_AGENT)) < 64u) { __builtin_amdgcn_s_sleep(2); if (++sp > (1u << 22)) break; }
            __builtin_amdgcn_fence(__ATOMIC_ACQUIRE, "agent");
            asm volatile("s_waitcnt vmcnt(0)" ::: "memory"); }
        asm volatile("" ::: "memory"); __builtin_amdgcn_s_barrier(); asm volatile("" ::: "memory");
    }
};
struct MergeOrder {
    static constexpr bool GATHER = false;
    __device__ __forceinline__ void a_ready(const Unit&, int) const {}
    __device__ __forceinline__ void done(const Unit& u, int tid) const {
        if (u.aux == 3) { asm volatile("s_waitcnt vmcnt(0)" ::: "memory");
            if ((tid & 63) == 0) __hip_atomic_fetch_add(done_cnt + 64 * u.pm, 1u, __ATOMIC_RELAXED, __HIP_MEMORY_SCOPE_AGENT); }
    }
    unsigned* done_cnt;
    int nM, G, c;
    __device__ __forceinline__ bool next(int ui, Unit& u) const {
        const int rw = (nM * 4) % G, Gm = G - rw, ntile = nM * 8;
        if (c >= Gm) return false;
        long L = (long)(ui >> 2) * Gm + c; if (L >= ntile) return false;
        const int lastp = (nM % 8 == 1) ? 8 : 0;
        L = (L + ntile - lastp) % ntile;
        if (!dense_tile(L, nM, 8, u.pm, u.pn)) return false;
        const int i = ui & 3; u.aux = i;
        u.aoff = (unsigned)(u.pm * BM * D * 2 + i * 256 * 2); u.boff = (unsigned)((i * 1024 + u.pn * HALF) * 256 * 2); return true;
    }
};
template <bool GATHER_> struct MoeOrderT {
    static constexpr bool GATHER = GATHER_;
    const LAS int* tbl; int nunits, G, c, lda, ldb; const unsigned short* inv;
    unsigned* done_cnt;
    __device__ __forceinline__ bool next(int i, Unit& u) const {
        int L;
        if (GATHER) { L = i * G + c; if (L >= nunits) return false; }
        else {
            const int full = nunits / G, r = nunits - full * G, base_rounds = (full > 0) ? full - 1 : 0, light = G - r;
            if (i < base_rounds) L = i * G + c;
            else { if (c < r) return false; L = base_rounds * G + (c - r) + (i - base_rounds) * light; if (L >= nunits) return false; }
        }
        u.pm = L >> 2; const int pl = L & 3; const int e = __builtin_amdgcn_readfirstlane(tbl[u.pm]); u.pn = e * 4 + pl; u.aux = e;
        u.aoff = GATHER ? 0u : (unsigned)(u.pm * BM * lda * 2); u.boff = (unsigned)(u.pn * BM * ldb * 2); return true;
    }
    __device__ __forceinline__ unsigned arow(const Unit& u, int r) const {
        const int e = u.aux, st = __builtin_amdgcn_readfirstlane(tbl[160 + e]), cn = __builtin_amdgcn_readfirstlane(tbl[176 + e]);
        const int slot = u.pm * BM + r - st;
        const unsigned tok = (slot < cn) ? (unsigned)inv[(size_t)e * MT + slot] : 0u;
        return tok * (unsigned)(lda * 2);
    }
    __device__ __forceinline__ void done(const Unit& u, int tid) const {
        if (GATHER) { asm volatile("s_waitcnt vmcnt(0)" ::: "memory");
            if ((tid & 63) == 0) __hip_atomic_fetch_add(done_cnt + 64 * u.pm, 1u, __ATOMIC_RELAXED, __HIP_MEMORY_SCOPE_AGENT); }
    }
    __device__ __forceinline__ void a_ready(const Unit& u, int tid) const {
        if (!GATHER) {
            if (tid < 64) { unsigned sp = 0;
                while ((unsigned)__builtin_amdgcn_readfirstlane(__hip_atomic_load(done_cnt + 64 * u.pm, __ATOMIC_RELAXED, __HIP_MEMORY_SCOPE_AGENT)) < 32u) { __builtin_amdgcn_s_sleep(2); if (++sp > (1u << 22)) break; }
                __builtin_amdgcn_fence(__ATOMIC_ACQUIRE, "agent");
                asm volatile("s_waitcnt vmcnt(0)" ::: "memory"); }
            asm volatile("" ::: "memory"); __builtin_amdgcn_s_barrier(); asm volatile("" ::: "memory");
        }
    }
};
__device__ __forceinline__ int moe_table(LAS int* tbl, const unsigned* cnt, int tid) {
    int pst[NE], cn[NE]; int tot = 0;
#pragma unroll
    for (int e = 0; e < NE; ++e) { cn[e] = (int)__builtin_amdgcn_readfirstlane(__hip_atomic_load(cnt + e * 64, __ATOMIC_RELAXED, __HIP_MEMORY_SCOPE_AGENT)); pst[e] = tot; tot += (cn[e] + 255) / 256 * 256; }
    if (tid < 160) { int e = 0;
#pragma unroll
        for (int k = 1; k < NE; ++k) if (tid * 256 >= pst[k]) e = k;
        tbl[tid] = e; }
#pragma unroll
    for (int e = 0; e < NE; ++e) if (tid == 160 + e) { tbl[160 + e] = pst[e]; tbl[176 + e] = cn[e]; }
    __syncthreads();
    return tot / 256;
}

template <class Epi, class Sched>
__device__ __forceinline__ void gemm_phase(LAS unsigned char* lds, int tid, const Gemm g, const Sched& S, const Epi& E) {
    const int wid = __builtin_amdgcn_readfirstlane(tid >> 6), lane = tid & 63, wr = wid >> 2, wc = wid & 3, fr = lane & 15, fq = lane >> 4;
    const int K = g.K, nt = K / BK;
    unsigned cv0[2], cv1[2], nv0[2], nv1[2], voffB[2]; int RA[2], CA[2];
#pragma unroll
    for (int i = 0; i < 2; ++i) { int R, C; stage_rc(tid * 16 + i * 8192, R, C); const int Rb = Epi::PERM ? ((R & ~31) + perm32(R & 31)) : R; RA[i] = R; CA[i] = C;
        cv0[i] = (unsigned)(R * g.lda + C) * 2u; cv1[i] = cv0[i] + (unsigned)(HALF * g.lda * 2); nv0[i] = cv0[i]; nv1[i] = cv1[i]; voffB[i] = (unsigned)(Rb * g.ldb + C) * 2u; }
    const size_t kstep = (size_t)(BK * 2);
    const size_t hsB = (size_t)HALF * g.ldb * 2;
    const unsigned ldsw = (unsigned)wid * 1024u;
    const int aoff = lds_byte(wr * 64 + fr, fq * 8), boff = lds_byte(wc * 32 + fr, fq * 8), aoff1 = lds_byte(wr * 64 + fr, 32 + fq * 8), boff1 = lds_byte(wc * 32 + fr, 32 + fq * 8);
#define PG8_SA(b, h) (((b) * 2 + (h)) * HTB)
#define PG8_SB(b, h) ((4 + (b) * 2 + (h)) * HTB)
#define PG8_STAGE(bufoff, gbase, voff) do { _Pragma("unroll") for (int _i = 0; _i < 2; ++_i) \
        __builtin_amdgcn_global_load_lds((const unsigned*)((const char*)(gbase) + (voff)[_i]), (LAS unsigned*)(lds + (bufoff) + ldsw + _i * 8192), 16, 0, 0); } while (0)
#define PG8_LDA(dst, b, h) do { _Pragma("unroll") for (int m = 0; m < 4; ++m) _Pragma("unroll") for (int k = 0; k < 2; ++k) dst[m][k] = *(const LAS bf16x8*)(lds + PG8_SA(b, h) + (k ? aoff1 : aoff) + m * 2048); } while (0)
#define PG8_LDB(dst, b, h) do { _Pragma("unroll") for (int n = 0; n < 2; ++n) _Pragma("unroll") for (int k = 0; k < 2; ++k) dst[n][k] = *(const LAS bf16x8*)(lds + PG8_SB(b, h) + (k ? boff1 : boff) + n * 2048); } while (0)
#define PG8_MMA(ai, bj, At, Bt) do { __builtin_amdgcn_s_setprio(1); _Pragma("unroll") for (int m = 0; m < 4; ++m) _Pragma("unroll") for (int n = 0; n < 2; ++n) _Pragma("unroll") for (int k = 0; k < 2; ++k) \
        acc[ai][bj][m][n] = __builtin_amdgcn_mfma_f32_16x16x32_bf16(Bt[n][k], At[m][k], acc[ai][bj][m][n], 0, 0, 0); __builtin_amdgcn_s_setprio(0); } while (0)
#define PG8_WAIT_V(n) asm volatile("s_waitcnt vmcnt(" #n ")" ::: "memory")
#define PG8_WAIT_L(n) asm volatile("s_waitcnt lgkmcnt(" #n ")" ::: "memory")
#define PG8_BAR __builtin_amdgcn_s_barrier()
#define PG8_SCHED __builtin_amdgcn_sched_barrier(0)
    Unit cur, nxt; int ui = 0;
    if (!S.next(0, cur)) return;
    S.a_ready(cur, tid);
    f32x4 acc[2][2][4][2];
#pragma unroll
    for (int a = 0; a < 2; ++a)
#pragma unroll
        for (int b = 0; b < 2; ++b)
#pragma unroll
            for (int m = 0; m < 4; ++m)
#pragma unroll
                for (int n = 0; n < 2; ++n) acc[a][b][m][n] = (f32x4){0.f, 0.f, 0.f, 0.f};
    bf16x8 At[4][2], B0[2][2], B1[2][2];
    const char* cA = (const char*)g.A + cur.aoff; const char* cB = (const char*)g.Bt + cur.boff;
    if constexpr (Sched::GATHER) {
#pragma unroll
        for (int i = 0; i < 2; ++i) { cv0[i] = S.arow(cur, RA[i]) + (unsigned)(CA[i] * 2); cv1[i] = S.arow(cur, HALF + RA[i]) + (unsigned)(CA[i] * 2); nv0[i] = cv0[i]; nv1[i] = cv1[i]; }
    }
    PG8_STAGE(PG8_SB(0, 0), cB, voffB); PG8_STAGE(PG8_SB(0, 1), cB + hsB, voffB); PG8_STAGE(PG8_SA(0, 0), cA, cv0); PG8_STAGE(PG8_SA(0, 1), cA, cv1);
    if (wr == 1) PG8_BAR;
    PG8_WAIT_V(2); PG8_BAR;
    PG8_STAGE(PG8_SB(1, 0), cB + kstep, voffB); PG8_STAGE(PG8_SA(1, 0), cA + kstep, cv0); PG8_STAGE(PG8_SB(1, 1), cB + hsB + kstep, voffB);
    PG8_WAIT_V(6); PG8_BAR;
    for (;;) {
        const bool has_next = S.next(ui + 1, nxt);
        const char* nA = has_next ? (const char*)g.A + nxt.aoff : cA; const char* nB = has_next ? (const char*)g.Bt + nxt.boff : cB;
        if constexpr (Sched::GATHER) {
#pragma unroll
            for (int i = 0; i < 2; ++i) { nv0[i] = has_next ? S.arow(nxt, RA[i]) + (unsigned)(CA[i] * 2) : cv0[i]; nv1[i] = has_next ? S.arow(nxt, HALF + RA[i]) + (unsigned)(CA[i] * 2) : cv1[i]; }
        }
        for (int t = 0; t < nt; t += 2) {
            const bool last = (t == nt - 2);
            const char* a1 = cA + (size_t)(t + 1) * kstep;
            const char* a2 = last ? nA : cA + (size_t)(t + 2) * kstep; const char* b2 = last ? nB : cB + (size_t)(t + 2) * kstep;
            const char* a3 = a2 + kstep; const char* b3 = b2 + kstep;
            if (last && has_next) S.a_ready(nxt, tid);
            unsigned s0[2], s1[2];
#pragma unroll
            for (int i = 0; i < 2; ++i) { s0[i] = (Sched::GATHER && last) ? nv0[i] : cv0[i]; s1[i] = (Sched::GATHER && last) ? nv1[i] : cv1[i]; }
            PG8_LDB(B0, 0, 0); if constexpr (!Epi::HALFN) PG8_LDB(B1, 0, 1); PG8_SCHED; PG8_LDA(At, 0, 0); PG8_STAGE(PG8_SA(1, 1), a1, cv1);
            PG8_WAIT_V(8); PG8_WAIT_L(0); PG8_BAR; PG8_MMA(0, 0, At, B0); if constexpr (!Epi::HALFN) PG8_MMA(0, 1, At, B1); PG8_BAR; PG8_SCHED;
            PG8_LDA(At, 0, 1); PG8_STAGE(PG8_SB(0, 0), b2, voffB); PG8_STAGE(PG8_SB(0, 1), b2 + hsB, voffB); PG8_STAGE(PG8_SA(0, 0), a2, s0);
            PG8_WAIT_V(8); PG8_WAIT_L(0); PG8_BAR; PG8_MMA(1, 0, At, B0); if constexpr (!Epi::HALFN) PG8_MMA(1, 1, At, B1); PG8_BAR; PG8_SCHED;
            PG8_LDB(B0, 1, 0); if constexpr (!Epi::HALFN) PG8_LDB(B1, 1, 1); PG8_SCHED; PG8_LDA(At, 1, 0); PG8_STAGE(PG8_SA(0, 1), a2, s1);
            PG8_WAIT_V(8); PG8_WAIT_L(0); PG8_BAR; PG8_MMA(0, 0, At, B0); if constexpr (!Epi::HALFN) PG8_MMA(0, 1, At, B1); PG8_BAR; PG8_SCHED;
            PG8_LDA(At, 1, 1); PG8_STAGE(PG8_SB(1, 0), b3, voffB); PG8_STAGE(PG8_SB(1, 1), b3 + hsB, voffB); PG8_STAGE(PG8_SA(1, 0), a3, s0);
            PG8_WAIT_V(8); PG8_WAIT_L(0); PG8_BAR; PG8_MMA(1, 0, At, B0); if constexpr (!Epi::HALFN) PG8_MMA(1, 1, At, B1); PG8_BAR; PG8_SCHED;
        }
        if (wr == 0) PG8_BAR;
        { int l2_; asm volatile("v_mbcnt_lo_u32_b32 %0, -1, 0\n\tv_mbcnt_hi_u32_b32 %0, -1, %0" : "=v"(l2_)); E(acc, cur, wr, wc, l2_ & 15, l2_ >> 4); }
        S.done(cur, tid);
        if (!has_next) break;
        if constexpr (!Epi::HALFN)
#pragma unroll
        for (int a = 0; a < 2; ++a)
#pragma unroll
            for (int b = 0; b < 2; ++b)
#pragma unroll
                for (int m = 0; m < 4; ++m)
#pragma unroll
                    for (int n = 0; n < 2; ++n) acc[a][b][m][n] = (f32x4){0.f, 0.f, 0.f, 0.f};
        cur = nxt; cA = nA; cB = nB; ++ui;
        if constexpr (Sched::GATHER) {
#pragma unroll
            for (int i = 0; i < 2; ++i) { cv0[i] = nv0[i]; cv1[i] = nv1[i]; }
        }
        if (wr == 1) PG8_BAR;
    }
    PG8_WAIT_V(0);
    PG8_BAR;
#undef PG8_SA
#undef PG8_SB
#undef PG8_STAGE
#undef PG8_LDA
#undef PG8_LDB
#undef PG8_MMA
#undef PG8_WAIT_V
#undef PG8_WAIT_L
#undef PG8_BAR
#undef PG8_SCHED
}

struct EpiIn {
    static constexpr bool HALFN = false;
    static constexpr bool PERM = true;
    bf16_t* Z; bf16_t* Gt; const float* bgate; const float* rope;
    __device__ __forceinline__ void operator()(f32x4 (&acc)[2][2][4][2], const Unit& u, int wr, int wc, int fr, int fq) const {
        const int row0 = u.pm * BM + wr * 64 + fr;
        if (u.pn < 11) {
            const bool dorope = (u.pn == 5 || u.pn == 6 || u.pn == 8) && (u.pm < SEQ / BM);
            const int col0 = u.pn * BM + wc * 32 + 8 * fq;
#pragma unroll
            for (int ai = 0; ai < 2; ++ai)
#pragma unroll
                for (int m = 0; m < 4; ++m) {
                    const int row = row0 + ai * HALF + m * 16;
                    f32x4 cs0, cs1, sn0, sn1;
                    if (dorope) { const int pos = (fq & 1) ? (row & 63) : (row >> 6); const f32x4* rp = (const f32x4*)(rope + pos * 16); cs0 = rp[0]; cs1 = rp[1]; sn0 = rp[2]; sn1 = rp[3]; }
#pragma unroll
                    for (int bj = 0; bj < 2; ++bj) {
                        f32x4 v0 = acc[ai][bj][m][0], v1 = acc[ai][bj][m][1];
                        if (dorope) {
                            f32x4 o0, o1;
#pragma unroll
                            for (int e = 0; e < 4; ++e) { o0[e] = swap32_other(v0[e], fq * 16); o1[e] = swap32_other(v1[e], fq * 16); }
                            if (fq < 2) { v0 = v0 * cs0 - o0 * sn0; v1 = v1 * cs1 - o1 * sn1; }
                            else        { v0 = o0 * sn0 + v0 * cs0; v1 = o1 * sn1 + v1 * cs1; }
                        }
                        float sc = 1.f; if (u.pn == 5) sc = QSCALE; if (u.pn == 8 && bj == 1) sc = RKSCALE;
                        v0 = v0 * sc; v1 = v1 * sc;
                        u32x4 w; w.x = cvtpk(v0[0], v0[1]); w.y = cvtpk(v0[2], v0[3]); w.z = cvtpk(v1[0], v1[1]); w.w = cvtpk(v1[2], v1[3]);
                        *(u32x4*)(Z + (size_t)row * ZLD + col0 + bj * HALF) = w;
                    }
                    asm volatile("" ::: "memory");
                }
        } else {
            const int col0 = (u.pn - 11) * BM + wc * 32 + 8 * fq;
            f32x4 bv[2][2];
#pragma unroll
            for (int bj = 0; bj < 2; ++bj)
#pragma unroll
                for (int n = 0; n < 2; ++n) bv[bj][n] = *(const f32x4*)(bgate + col0 + bj * HALF + 4 * n) * -1.4426950408889634f;
#pragma unroll
            for (int ai = 0; ai < 2; ++ai)
#pragma unroll
                for (int m = 0; m < 4; ++m) {
                    const int row = row0 + ai * HALF + m * 16;
#pragma unroll
                    for (int bj = 0; bj < 2; ++bj) {
                        f32x4 v0, v1;
#pragma unroll
                        for (int e = 0; e < 4; ++e) { v0[e] = __builtin_amdgcn_rcpf(1.f + __builtin_amdgcn_exp2f(__builtin_fmaf(acc[ai][bj][m][0][e], -1.4426950408889634f, bv[bj][0][e])));
                                                      v1[e] = __builtin_amdgcn_rcpf(1.f + __builtin_amdgcn_exp2f(__builtin_fmaf(acc[ai][bj][m][1][e], -1.4426950408889634f, bv[bj][1][e]))); }
                        u32x4 w; w.x = cvtpk(v0[0], v0[1]); w.y = cvtpk(v0[2], v0[3]); w.z = cvtpk(v1[0], v1[1]); w.w = cvtpk(v1[2], v1[3]);
                        *(u32x4*)(Gt + (size_t)row * GLD + col0 + bj * HALF) = w;
                    }
                    asm volatile("" ::: "memory");
                }
        }
    }
};
struct EpiMerge {
    static constexpr bool PERM = true, HALFN = true;
    const bf16_t* Gt; bf16_t* Mb;
    __device__ __forceinline__ void operator()(f32x4 (&acc)[2][2][4][2], const Unit& u, int wr, int wc, int fr, int fq) const {
        const int row0 = u.pm * BM + wr * 64 + fr, col0 = u.pn * HALF + wc * 32 + 8 * fq, i = u.aux;
        u32x4 gw[2][4];
#pragma unroll
        for (int ai = 0; ai < 2; ++ai)
#pragma unroll
            for (int m = 0; m < 4; ++m) gw[ai][m] = *(const u32x4*)(Gt + (size_t)(row0 + ai * HALF + m * 16) * GLD + i * 1024 + col0);
#pragma unroll
        for (int ai = 0; ai < 2; ++ai)
#pragma unroll
            for (int m = 0; m < 4; ++m) {
                const u32x4 g = gw[ai][m];
                const f32x4 v0 = acc[ai][0][m][0], v1 = acc[ai][0][m][1];
                f32x4& s0 = acc[ai][1][m][0]; f32x4& s1 = acc[ai][1][m][1];
                s0[0] += v0[0] * bflo(g.x); s0[1] += v0[1] * bfhi(g.x); s0[2] += v0[2] * bflo(g.y); s0[3] += v0[3] * bfhi(g.y);
                s1[0] += v1[0] * bflo(g.z); s1[1] += v1[1] * bfhi(g.z); s1[2] += v1[2] * bflo(g.w); s1[3] += v1[3] * bfhi(g.w);
                acc[ai][0][m][0] = (f32x4){0.f, 0.f, 0.f, 0.f}; acc[ai][0][m][1] = (f32x4){0.f, 0.f, 0.f, 0.f};
            }
        if (i == 3) {
#pragma unroll
            for (int ai = 0; ai < 2; ++ai)
#pragma unroll
                for (int m = 0; m < 4; ++m) {
                    f32x4& s0 = acc[ai][1][m][0]; f32x4& s1 = acc[ai][1][m][1];
                    u32x4 w; w.x = cvtpk(s0[0], s0[1]); w.y = cvtpk(s0[2], s0[3]); w.z = cvtpk(s1[0], s1[1]); w.w = cvtpk(s1[2], s1[3]);
                    st16_wt(Mb + (size_t)(row0 + ai * HALF + m * 16) * D + col0, w);
                    s0 = (f32x4){0.f, 0.f, 0.f, 0.f}; s1 = (f32x4){0.f, 0.f, 0.f, 0.f};
                }
        }
    }
};
struct EpiWo {
    static constexpr bool HALFN = false;
    static constexpr bool PERM = false;
    const float* base_l; float* out_l; const float* base_c; float* out_c; const float* gate_l; const float* gate_c;
    __device__ __forceinline__ void operator()(f32x4 (&acc)[2][2][4][2], const Unit& u, int wr, int wc, int fr, int fq) const {
        const bool isc = (u.pm == SEQ / BM);
        const float* base = isc ? base_c : base_l; float* out = isc ? out_c : out_l; const float* gate = isc ? gate_c : gate_l;
        const int row0 = (isc ? 0 : u.pm * BM) + wr * 64 + fr, col0 = u.pn * BM + wc * 32 + 4 * fq;
        f32x4 gv[2][2];
#pragma unroll
        for (int bj = 0; bj < 2; ++bj)
#pragma unroll
            for (int n = 0; n < 2; ++n) gv[bj][n] = *(const f32x4*)(gate + col0 + bj * HALF + n * 16);
#pragma unroll
        for (int ai = 0; ai < 2; ++ai) {
            f32x4 b[4][2][2];
#pragma unroll
            for (int m = 0; m < 4; ++m) { const size_t off = (size_t)(row0 + ai * HALF + m * 16) * D + col0;
#pragma unroll
                for (int bj = 0; bj < 2; ++bj)
#pragma unroll
                    for (int n = 0; n < 2; ++n) b[m][bj][n] = *(const f32x4*)(base + off + bj * HALF + n * 16); }
#pragma unroll
            for (int m = 0; m < 4; ++m) { const size_t off = (size_t)(row0 + ai * HALF + m * 16) * D + col0;
#pragma unroll
                for (int bj = 0; bj < 2; ++bj)
#pragma unroll
                    for (int n = 0; n < 2; ++n) *(f32x4*)(out + off + bj * HALF + n * 16) = b[m][bj][n] + gv[bj][n] * acc[ai][bj][m][n]; }
            asm volatile("" ::: "memory");
        }
    }
};
struct EpiE1 {
    static constexpr bool HALFN = false;
    static constexpr bool PERM = true;
    bf16_t* U;
    __device__ __forceinline__ void operator()(f32x4 (&acc)[2][2][4][2], const Unit& u, int wr, int wc, int fr, int fq) const {
        const int row0 = u.pm * BM + wr * 64 + fr, col0 = (u.pn & 3) * 128 + wc * 32 + 8 * fq;
#pragma unroll
        for (int ai = 0; ai < 2; ++ai)
#pragma unroll
            for (int m = 0; m < 4; ++m) {
                const int row = row0 + ai * HALF + m * 16;
                f32x4 v0, v1;
#pragma unroll
                for (int e = 0; e < 4; ++e) { v0[e] = siluf_(acc[ai][0][m][0][e]) * acc[ai][1][m][0][e]; v1[e] = siluf_(acc[ai][0][m][1][e]) * acc[ai][1][m][1][e]; }
                u32x4 w; w.x = cvtpk(v0[0], v0[1]); w.y = cvtpk(v0[2], v0[3]); w.z = cvtpk(v1[0], v1[1]); w.w = cvtpk(v1[2], v1[3]);
                st16_wt(U + (size_t)row * FFE + col0, w);
                asm volatile("" ::: "memory");
            }
    }
};
struct EpiE2 {
    static constexpr bool HALFN = false;
    static constexpr bool PERM = true;
    bf16_t* Ys;
    __device__ __forceinline__ void operator()(f32x4 (&acc)[2][2][4][2], const Unit& u, int wr, int wc, int fr, int fq) const {
        const int row0 = u.pm * BM + wr * 64 + fr, col0 = (u.pn & 3) * BM + wc * 32 + 8 * fq;
#pragma unroll
        for (int ai = 0; ai < 2; ++ai)
#pragma unroll
            for (int m = 0; m < 4; ++m) {
                const int row = row0 + ai * HALF + m * 16;
#pragma unroll
                for (int bj = 0; bj < 2; ++bj) { const f32x4 v0 = acc[ai][bj][m][0], v1 = acc[ai][bj][m][1];
                    u32x4 w; w.x = cvtpk(v0[0], v0[1]); w.y = cvtpk(v0[2], v0[3]); w.z = cvtpk(v1[0], v1[1]); w.w = cvtpk(v1[2], v1[3]);
                    *(u32x4*)(Ys + (size_t)row * D + col0 + bj * HALF) = w; }
                asm volatile("" ::: "memory");
            }
    }
};
}

#define XB_TMO      128
#define XB_XCNT(j)  (256  + 64 * (j))
#define XB_XSUB(j)  (1280 + 64 * (j))
#define XB_XGEN(j)  (2304 + 64 * (j))
#define XB_TOP      3328
#define XB_TOPGEN   3392
#define XCD_BAR_WORDS 3456
#define XB_SPIN_CAP (1u << 20)
__device__ __forceinline__ unsigned xb_ld(unsigned* p)              { return __hip_atomic_load(p, __ATOMIC_RELAXED, __HIP_MEMORY_SCOPE_AGENT); }
__device__ __forceinline__ unsigned xb_add(unsigned* p, unsigned v) { return __hip_atomic_fetch_add(p, v, __ATOMIC_RELAXED, __HIP_MEMORY_SCOPE_AGENT); }
__device__ __forceinline__ unsigned xb_xcc_id() { return (unsigned)__builtin_amdgcn_s_getreg((3 << 11) | 20) & 0xFu; }
#define XB_SPIN(cond, bar) do { unsigned _sp = 0; while (cond) { __builtin_amdgcn_s_sleep(1); \
    if ((++_sp & 255u) == 0u) { if (xb_ld(&(bar)[XB_TMO])) break; if (_sp > XB_SPIN_CAP) { atomicAdd(&(bar)[XB_TMO], 1u); break; } } } } while (0)
__device__ __forceinline__ void xcd_barrier_complete(unsigned* bar, unsigned x, unsigned G, unsigned& nloc, unsigned& nx) {
    unsigned sum, cnt, mine, sp = 0u;
    for (;;) {
        sum = 0u; cnt = 0u; mine = 0u;
#pragma unroll
        for (unsigned j = 0; j < 16; ++j) { const unsigned c = xb_ld(&bar[XB_XCNT(j)]); sum += c; cnt += (c > 0u) ? 1u : 0u; mine = (j == x) ? c : mine; }
        if (sum == G) break;
        __builtin_amdgcn_s_sleep(1);
        if ((++sp & 255u) == 0u) { if (xb_ld(&bar[XB_TMO])) break; if (sp > XB_SPIN_CAP) { atomicAdd(&bar[XB_TMO], 1u); break; } }
    }
    nloc = mine > 0u ? mine : 1u; nx = cnt > 0u ? cnt : 1u;
}
__device__ __forceinline__ void xcd_barrier(unsigned* bar, volatile LAS unsigned* st, int tid, unsigned G) {
    asm volatile("s_waitcnt vmcnt(0)" ::: "memory");
    __syncthreads();
    if (tid == 0) {
        const unsigned x = xb_xcc_id();
        __builtin_amdgcn_s_waitcnt(0);
        unsigned nloc = st[0], nx = st[1];
        if (nloc == 0u) { xcd_barrier_complete(bar, x, G, nloc, nx); st[0] = nloc; st[1] = nx; }
        const unsigned old = xb_add(&bar[XB_XSUB(x)], 1u);
        const unsigned gen = old / nloc;
        if (old + 1u == (gen + 1u) * nloc) {
            __builtin_amdgcn_fence(__ATOMIC_RELEASE, "agent");
            asm volatile("s_waitcnt vmcnt(0)" ::: "memory");
            const unsigned og = xb_add(&bar[XB_TOP], 1u);
            const unsigned tg = og / nx;
            if (og + 1u == (tg + 1u) * nx) xb_add(&bar[XB_TOPGEN], 1u);
            else XB_SPIN(xb_ld(&bar[XB_TOPGEN]) == tg, bar);
            __builtin_amdgcn_fence(__ATOMIC_ACQUIRE, "agent");
            xb_add(&bar[XB_XGEN(x)], 1u);
            asm volatile("s_waitcnt vmcnt(0)" ::: "memory");
        } else {
            XB_SPIN(xb_ld(&bar[XB_XGEN(x)]) == gen, bar);
            __builtin_amdgcn_fence(__ATOMIC_ACQUIRE, "agent");
            asm volatile("s_waitcnt vmcnt(0)" ::: "memory");
        }
    }
    __syncthreads();
}

struct Args { const float* in[31]; float* out; unsigned char* ws; int ph_lo, ph_hi; };
struct Frame {
    LAS unsigned char* lds;
    int tid, lane, wave, G, bid, gw, NGW;
    const float* const* in; float* out; unsigned char* ws;
};
#define WSP(T, off) ((T*)(F.ws + (off)))

__device__ __forceinline__ void transpose_item(const float* W, int K, int N, bf16_t* WT, int row_off, int imode, LAS float* scr, int item, int lane) {
    const int nblk = N / 64, kb = item / nblk, nb = item % nblk, k0 = 64 * kb, n0 = 64 * nb;
    const int q = lane & 15, r = lane >> 4;
    f32x4 v[16];
#pragma unroll
    for (int i = 0; i < 16; ++i) v[i] = __builtin_nontemporal_load((const f32x4*)(W + (size_t)(k0 + 4 * i + r) * N + n0 + 4 * q));
#pragma unroll
    for (int i = 0; i < 16; ++i) { LAS float* d = scr + (4 * i + r) * 65 + 4 * q; d[0] = v[i][0]; d[1] = v[i][1]; d[2] = v[i][2]; d[3] = v[i][3]; }
    LDS_WAIT(); asm volatile("" ::: "memory");
    const int c = lane & 7;
#pragma unroll
    for (int j = 0; j < 8; ++j) { const int n = (lane >> 3) + 8 * j; const LAS float* s_ = scr + (8 * c) * 65 + n;
        u32x4 o; o.x = cvtpk(s_[0 * 65], s_[1 * 65]); o.y = cvtpk(s_[2 * 65], s_[3 * 65]); o.z = cvtpk(s_[4 * 65], s_[5 * 65]); o.w = cvtpk(s_[6 * 65], s_[7 * 65]);
        const int ng = n0 + n; const int drow = (imode == 0) ? ng : ((ng >> 7) * 256 + (ng & 127) + (imode == 2 ? 128 : 0));
        *(u32x4*)(WT + (size_t)(row_off + drow) * K + k0 + 8 * c) = o; }
    LDS_WAIT(); asm volatile("" ::: "memory");
}
__device__ __forceinline__ void convert_weights(Frame& F, int l, int part) {
    LAS float* scr = (LAS float*)(F.lds + F.wave * 17408);
    constexpr int I_IN = 16 * 44, I_G = 16 * 64, I_B = 4 * 16, I_O = 16 * 16, I_1 = 16 * 8, I_2 = 8 * 16;
    constexpr int N0 = I_IN + I_G + 4 * I_B + I_O, N1 = 16 * 2 * I_1, N2 = 16 * I_2;
    bf16_t* WIN = WSP(bf16_t, WS_WIN); bf16_t* WB = WSP(bf16_t, WS_WB); bf16_t* WO = WSP(bf16_t, WS_WO); bf16_t* W13 = WSP(bf16_t, WS_W13); bf16_t* W2 = WSP(bf16_t, WS_W2);
    const int nitems = (part == 0) ? N0 : (part == 1) ? N1 : N2;
    for (int it = F.gw; it < nitems; it += F.NGW) {
        int r = it;
        if (part == 0) {
            if (r < I_IN) { transpose_item(F.in[8] + (size_t)l * D * ZLD, D, ZLD, WIN, 0, 0, scr, r, F.lane); continue; } r -= I_IN;
            if (r < I_G) { transpose_item(F.in[21] + (size_t)l * D * GLD, D, GLD, WIN, ZLD, 0, scr, r, F.lane); continue; } r -= I_G;
            if (r < 4 * I_B) { const int i = r / I_B; transpose_item(F.in[23] + ((size_t)l * 4 + i) * 256 * D, 256, D, WB + (size_t)i * 1024 * 256, 0, 0, scr, r % I_B, F.lane); continue; } r -= 4 * I_B;
            transpose_item(F.in[24] + (size_t)l * D * D, D, D, WO, 0, 0, scr, r, F.lane);
        } else if (part == 1) {
            const int e = r / (2 * I_1); r -= e * (2 * I_1);
            if (r < I_1) transpose_item(F.in[27] + ((size_t)l * NE + e) * D * FFE, D, FFE, W13 + (size_t)e * 1024 * 1024, 0, 1, scr, r, F.lane);
            else transpose_item(F.in[28] + ((size_t)l * NE + e) * D * FFE, D, FFE, W13 + (size_t)e * 1024 * 1024, 0, 2, scr, r - I_1, F.lane);
        } else {
            const int e = r / I_2; r -= e * I_2;
            transpose_item(F.in[29] + ((size_t)l * NE + e) * FFE * D, FFE, D, W2 + (size_t)e * 1024 * 512, 0, 0, scr, r, F.lane);
        }
    }
}
__device__ __forceinline__ void mod_items(Frame& F) {
    float* modp = WSP(float, WS_MODP);
    for (int item = F.gw; item < 2 * 96 * 8; item += F.NGW) {
        const int kg = item & 7, cc = item >> 3, l = cc / 96, c0 = (cc % 96) * 64, col = c0 + F.lane, k0 = kg * 128;
        const float* w = F.in[4] + (size_t)l * D * 6144 + col;
        float s0 = 0.f, s1 = 0.f;
#pragma unroll 1
        for (int kb = 0; kb < 128; kb += 32) {
            float wv[32];
#pragma unroll
            for (int k = 0; k < 32; ++k) wv[k] = w[(size_t)(k0 + kb + k) * 6144];
#pragma unroll
            for (int k = 0; k < 32; ++k) { s0 += siluf_(F.in[1][k0 + kb + k]) * wv[k]; s1 += siluf_(F.in[3][k0 + kb + k]) * wv[k]; }
        }
        modp[(((size_t)kg * 2 + l) * 2 + 0) * 6144 + col] = s0; modp[(((size_t)kg * 2 + l) * 2 + 1) * 6144 + col] = s1;
    }
}
__device__ __forceinline__ float modv_reduce(Frame& F, int l, int v, int idx) {
    const float* modp = WSP(float, WS_MODP); float s = F.in[5][(size_t)l * 6144 + idx];
#pragma unroll
    for (int kg = 0; kg < 8; ++kg) s += modp[(((size_t)kg * 2 + l) * 2 + v) * 6144 + idx];
    return s;
}
__device__ __forceinline__ void rope_table(Frame& F) {
    if (F.bid != F.G - 1) return;
    float* tab = WSP(float, WS_ROPE);
    for (int idx = F.tid; idx < 256 * 8; idx += NTHR) {
        const int pos = idx >> 3, i = idx & 7;
        const float inv = (i == 0) ? 1.0f : (i == 1) ? 0.31622776601683794f : (i == 2) ? 0.1f : (i == 3) ? 0.031622776601683794f : (i == 4) ? 0.01f : (i == 5) ? 0.0031622776601683794f : (i == 6) ? 0.001f : 0.00031622776601683794f;
        const float a = (float)pos * inv;
        const float q = rintf(a * 0.6366197723675814f);
        const float r = ((a - q * 1.5703125f) - q * 4.837512969970703125e-4f) - q * 7.54978995489188e-8f;
        const float r2 = r * r;
        const float sn = r + r * r2 * (-1.6666667e-1f + r2 * (8.3333333e-3f + r2 * (-1.984127e-4f + r2 * 2.7557319e-6f)));
        const float cs = 1.0f + r2 * (-0.5f + r2 * (4.1666667e-2f + r2 * (-1.3888889e-3f + r2 * (2.4801587e-5f + r2 * -2.7557319e-7f))));
        const int qi = ((int)q) & 3;
        const float c = (qi == 0) ? cs : (qi == 1) ? -sn : (qi == 2) ? -cs : sn;
        const float s = (qi == 0) ? sn : (qi == 1) ? cs : (qi == 2) ? -sn : -cs;
        tab[pos * 16 + i] = c; tab[pos * 16 + 8 + i] = s;
    }
}

__device__ __forceinline__ void load_row(const float* p, f32x4 (&v)[4], int lane) {
#pragma unroll
    for (int j = 0; j < 4; ++j) v[j] = ((const f32x4*)p)[lane + 64 * j];
}
__device__ __forceinline__ void store_row(float* p, const f32x4 (&v)[4], int lane) {
#pragma unroll
    for (int j = 0; j < 4; ++j) ((f32x4*)p)[lane + 64 * j] = v[j];
}
__device__ __forceinline__ void store_row_bf16(bf16_t* p, const f32x4 (&v)[4], int lane) {
#pragma unroll
    for (int j = 0; j < 4; ++j) { u32x2 w; w.x = cvtpk(v[j][0], v[j][1]); w.y = cvtpk(v[j][2], v[j][3]); ((u32x2*)p)[lane + 64 * j] = w; }
}
__device__ __forceinline__ float row_rms(const f32x4 (&v)[4]) {
    float s = 0.f;
#pragma unroll
    for (int j = 0; j < 4; ++j) s += (v[j][0] * v[j][0] + v[j][1] * v[j][1]) + (v[j][2] * v[j][2] + v[j][3] * v[j][3]);
    return __builtin_amdgcn_rsqf(wave_sum(s) * (1.f / D) + EPS);
}
__device__ __forceinline__ void moe_combine(Frame& F, int row, const float* g5, f32x4 (&x)[4]) {
    const int* R = WSP(int, WS_ROUTE);
    const int pa = R[5 * MT + row], pb = R[6 * MT + row]; const float wa = __int_as_float(R[3 * MT + row]), wb = __int_as_float(R[4 * MT + row]);
    const bf16_t* Ys = WSP(bf16_t, WS_Z);
#pragma unroll
    for (int j = 0; j < 4; ++j) {
        const u32x2 a = ((const u32x2*)(Ys + (size_t)pa * D))[F.lane + 64 * j], b = ((const u32x2*)(Ys + (size_t)pb * D))[F.lane + 64 * j];
        const f32x4 g = ((const f32x4*)g5)[F.lane + 64 * j];
        x[j][0] += g[0] * (wa * bflo(a.x) + wb * bflo(b.x)); x[j][1] += g[1] * (wa * bfhi(a.x) + wb * bfhi(b.x));
        x[j][2] += g[2] * (wa * bflo(a.y) + wb * bflo(b.y)); x[j][3] += g[3] * (wa * bfhi(a.y) + wb * bfhi(b.y));
    }
}
template <int MODE, int NB>
__device__ __forceinline__ void rows_batched(Frame& F, const float* xin, float* xio, bf16_t* H, const f32x4 (&ca)[4], const f32x4 (&cb)[4], const float* g5, int r0, int r1, int rbase, bool isdup) {
    const int* R = WSP(int, WS_ROUTE); const bf16_t* Ys = WSP(bf16_t, WS_Z);
    for (int row0 = r0 + F.gw; row0 < r1; row0 += NB * F.NGW) {
        f32x4 x[NB][4]; u32x2 ya[NB][4], yb[NB][4]; float wa[NB], wb[NB];
#pragma unroll
        for (int k = 0; k < NB; ++k) { const int row = row0 + k * F.NGW; if (row < r1) {
            if (MODE == 0) {
#pragma unroll
                for (int j = 0; j < 4; ++j) x[k][j] = __builtin_nontemporal_load((const f32x4*)(xin + (size_t)(row - rbase) * D) + F.lane + 64 * j);
            } else load_row((const float*)xio + (size_t)(row - rbase) * D, x[k], F.lane);
            if (MODE != 0) { const int ee_ = R[0 * MT + row]; const int* pst_ = WSP(int, WS_META) + 256; const int pa = pst_[ee_ & 255] + R[1 * MT + row], pb = pst_[ee_ >> 8] + R[2 * MT + row]; wa[k] = __int_as_float(R[3 * MT + row]); wb[k] = __int_as_float(R[4 * MT + row]);
#pragma unroll
                for (int j = 0; j < 4; ++j) { ya[k][j] = ((const u32x2*)(Ys + (size_t)pa * D))[F.lane + 64 * j]; yb[k][j] = ((const u32x2*)(Ys + (size_t)pb * D))[F.lane + 64 * j]; } } } }
#pragma unroll
        for (int k = 0; k < NB; ++k) { const int row = row0 + k * F.NGW; if (row < r1) {
            if (MODE != 0) {
#pragma unroll
                for (int j = 0; j < 4; ++j) { const f32x4 g = ((const f32x4*)g5)[F.lane + 64 * j]; const u32x2 a = ya[k][j], b = yb[k][j];
                    x[k][j][0] += g[0] * (wa[k] * bflo(a.x) + wb[k] * bflo(b.x)); x[k][j][1] += g[1] * (wa[k] * bfhi(a.x) + wb[k] * bfhi(b.x));
                    x[k][j][2] += g[2] * (wa[k] * bflo(a.y) + wb[k] * bflo(b.y)); x[k][j][3] += g[3] * (wa[k] * bfhi(a.y) + wb[k] * bfhi(b.y)); }
                if (MODE == 1 && !isdup) store_row(xio + (size_t)(row - rbase) * D, x[k], F.lane);
            }
            const float rs = row_rms(x[k]);
            if (MODE == 2) {
#pragma unroll
                for (int j = 0; j < 4; ++j) x[k][j] = x[k][j] * rs * ca[j];
                store_row((isdup ? WSP(float, WS_G) : xio) + (size_t)(row - rbase) * D, x[k], F.lane);
            } else {
#pragma unroll
                for (int j = 0; j < 4; ++j) x[k][j] = x[k][j] * rs * ca[j] + cb[j];
                store_row_bf16(H + (size_t)row * D, x[k], F.lane);
            }
        } }
    }
}
__device__ __forceinline__ void norm1_phase(Frame& F, int l, bool isdup) {
    float* modv = WSP(float, WS_MODV); bf16_t* H = isdup ? WSP(bf16_t, WS_G) : WSP(bf16_t, WS_H); float* XC = WSP(float, WS_XC);
    if (l == 0 && !isdup) for (int idx = F.bid * NTHR + F.tid; idx < 2 * 2 * 6144; idx += F.G * NTHR) modv[idx] = modv_reduce(F, idx / 12288, (idx / 6144) & 1, idx % 6144);
    for (int v = 0; v < 2; ++v) {
        const float* mv = modv + ((size_t)l * 2 + v) * 6144; const float* mvp = modv + ((size_t)(l > 0 ? l - 1 : 0) * 2 + v) * 6144;
        f32x4 ca[4], cb[4];
#pragma unroll
        for (int j = 0; j < 4; ++j) { const f32x4 g = ((const f32x4*)(F.in[6] + (size_t)l * D))[F.lane + 64 * j]; f32x4 sh, sc;
            if (l == 0) {
#pragma unroll
                for (int e = 0; e < 4; ++e) { sh[e] = modv_reduce(F, 0, v, 4 * (F.lane + 64 * j) + e); sc[e] = modv_reduce(F, 0, v, D + 4 * (F.lane + 64 * j) + e); }
            } else { sh = ((const f32x4*)mv)[F.lane + 64 * j]; sc = ((const f32x4*)(mv + D))[F.lane + 64 * j]; }
            ca[j] = g * (sc + 1.f); cb[j] = sh; }
        const int r0 = v ? SEQ : 0, r1 = v ? MT : SEQ;
        if (l == 0) rows_batched<0, 4>(F, v ? F.in[2] : F.in[0], nullptr, H, ca, cb, nullptr, r0, r1, r0, isdup);
        else rows_batched<1, 4>(F, nullptr, v ? XC : F.out, H, ca, cb, mvp + 5 * D, r0, r1, r0, isdup);
    }
}
__device__ __forceinline__ void final_phase(Frame& F, bool isdup) {
    const float* mvp = WSP(float, WS_MODV) + ((size_t)1 * 2 + 0) * 6144;
    f32x4 gf[4];
#pragma unroll
    for (int j = 0; j < 4; ++j) gf[j] = ((const f32x4*)F.in[30])[F.lane + 64 * j];
    rows_batched<2, 4>(F, nullptr, F.out, nullptr, gf, gf, mvp + 5 * D, 0, SEQ, 0, isdup);
}
__device__ __forceinline__ void route_phase(Frame& F, int l, bool isdup) {
    LAS float* wrT = (LAS float*)F.lds;
    LAS unsigned* lcnt = (LAS unsigned*)(F.lds + 65536); LAS unsigned* lbase = lcnt + 16; LAS unsigned* lrec = lcnt + 32;
    if (F.tid < NE) lcnt[F.tid] = 0u;
    int nloc = 0;
    {
        f32x4 wv[8];
#pragma unroll
        for (int i = 0; i < 8; ++i) wv[i] = ((const f32x4*)F.in[25])[F.tid + NTHR * i];
#pragma unroll
        for (int i = 0; i < 8; ++i) { const int i4 = F.tid + NTHR * i, col = i4 >> 2, e0 = (i4 & 3) * 4;
            wrT[(e0 + 0) * D + col] = wv[i][0]; wrT[(e0 + 1) * D + col] = wv[i][1]; wrT[(e0 + 2) * D + col] = wv[i][2]; wrT[(e0 + 3) * D + col] = wv[i][3]; }
    }
    __syncthreads();
    const float* modv = WSP(float, WS_MODV); bf16_t* H2 = WSP(bf16_t, WS_H); float* XC = WSP(float, WS_XC);
    int* R = WSP(int, WS_ROUTE) + (isdup ? 8 * MT : 0); unsigned* cnt = WSP(unsigned, WS_CTL) + CW_CNT + l * 2048 + (isdup ? 1024 : 0);
    float br[NE];
#pragma unroll
    for (int e = 0; e < NE; ++e) br[e] = F.in[26][e];
    const int nv = (l == 1) ? 1 : 2;
    for (int v = 0; v < nv; ++v) {
        const float* mv = modv + ((size_t)l * 2 + v) * 6144;
        f32x4 ca[4], cb[4];
#pragma unroll
        for (int j = 0; j < 4; ++j) { const f32x4 g = ((const f32x4*)(F.in[7] + (size_t)l * D))[F.lane + 64 * j], sh = ((const f32x4*)(mv + 3 * D))[F.lane + 64 * j], sc = ((const f32x4*)(mv + 4 * D))[F.lane + 64 * j];
            ca[j] = g * (sc + 1.f); cb[j] = sh; }
        const int r0 = v ? SEQ : 0, r1 = v ? MT : SEQ;
        f32x4 xn[4];
        if (r0 + F.gw < r1) load_row(v ? XC + (size_t)(r0 + F.gw - SEQ) * D : F.out + (size_t)(r0 + F.gw) * D, xn, F.lane);
        for (int row = r0 + F.gw; row < r1; row += F.NGW) {
            f32x4 x[4];
#pragma unroll
            for (int j = 0; j < 4; ++j) x[j] = xn[j];
            if (row + F.NGW < r1) load_row(v ? XC + (size_t)(row + F.NGW - SEQ) * D : F.out + (size_t)(row + F.NGW) * D, xn, F.lane);
            const float rs = row_rms(x);
#pragma unroll
            for (int j = 0; j < 4; ++j) x[j] = x[j] * rs * ca[j] + cb[j];
            store_row_bf16(H2 + (size_t)row * D, x, F.lane);
            float sg[NE], sb[NE];
#pragma unroll
            for (int eg = 0; eg < NE; eg += 4) {
                f32x4 w[4][4];
#pragma unroll
                for (int q = 0; q < 4; ++q)
#pragma unroll
                    for (int j = 0; j < 4; ++j) w[q][j] = *(const LAS f32x4*)(wrT + (eg + q) * D + 4 * F.lane + 256 * j);
                float p[4];
#pragma unroll
                for (int q = 0; q < 4; ++q) { p[q] = 0.f;
#pragma unroll
                    for (int j = 0; j < 4; ++j) p[q] += (x[j][0] * w[q][j][0] + x[j][1] * w[q][j][1]) + (x[j][2] * w[q][j][2] + x[j][3] * w[q][j][3]); }
#pragma unroll
                for (int q = 0; q < 4; ++q) { p[q] = wave_sum(p[q]); sg[eg + q] = 1.f / (1.f + expf(-p[q])); sb[eg + q] = sg[eg + q] + br[eg + q]; }
                asm volatile("" ::: "memory");
            }
            float best = -INFINITY; int e1 = 0, e2 = 1; float s1 = 0.f, s2 = 0.f;
#pragma unroll
            for (int g = 0; g < 4; ++g) {
                int a = 0; float va = sb[4 * g];
#pragma unroll
                for (int k = 1; k < 4; ++k) if (sb[4 * g + k] > va) { va = sb[4 * g + k]; a = k; }
                int b = -1; float vb = -INFINITY;
#pragma unroll
                for (int k = 0; k < 4; ++k) if (k != a && sb[4 * g + k] > vb) { vb = sb[4 * g + k]; b = k; }
                const float gs = va + vb;
                if (gs > best) { best = gs; e1 = 4 * g + a; e2 = 4 * g + b;
                    float sa_ = 0.f, sb_ = 0.f;
#pragma unroll
                    for (int k = 0; k < 4; ++k) { if (k == a) sa_ = sg[4 * g + k]; if (k == b) sb_ = sg[4 * g + k]; }
                    s1 = sa_; s2 = sb_; }
            }
            if (F.lane == 0) {
                const float inv = 1.f / (s1 + s2);
                const unsigned la = __hip_atomic_fetch_add(lcnt + e1, 1u, __ATOMIC_RELAXED, __HIP_MEMORY_SCOPE_WORKGROUP), lb = __hip_atomic_fetch_add(lcnt + e2, 1u, __ATOMIC_RELAXED, __HIP_MEMORY_SCOPE_WORKGROUP);
                const int k = nloc++;
                lrec[(F.wave * 40 + k) * 4 + 0] = (unsigned)row; lrec[(F.wave * 40 + k) * 4 + 1] = (unsigned)(e1 | (e2 << 8)) | (la << 16); lrec[(F.wave * 40 + k) * 4 + 2] = lb;
                R[3 * MT + row] = __float_as_int(s1 * inv); R[4 * MT + row] = __float_as_int(s2 * inv);
            }
        }
    }
    __syncthreads();
    if (F.tid < NE) lbase[F.tid] = atomicAdd(cnt + F.tid * 64, lcnt[F.tid]);
    __syncthreads();
    if (F.lane == 0) {
        for (int k = 0; k < nloc; ++k) {
            const unsigned row = lrec[(F.wave * 40 + k) * 4 + 0], w1 = lrec[(F.wave * 40 + k) * 4 + 1], lb = lrec[(F.wave * 40 + k) * 4 + 2];
            const unsigned ea = w1 & 255u, eb = (w1 >> 8) & 255u, la = w1 >> 16;
            R[0 * MT + row] = (int)(ea | (eb << 8)); R[1 * MT + row] = (int)(lbase[ea] + la); R[2 * MT + row] = (int)(lbase[eb] + lb);
            if (!isdup) { unsigned short* inv = WSP(unsigned short, WS_INV); inv[(size_t)ea * MT + lbase[ea] + la] = (unsigned short)row; inv[(size_t)eb * MT + lbase[eb] + lb] = (unsigned short)row; }
        }
    }
    __syncthreads();
}
__device__ __forceinline__ void conv_a_tile(Frame& F, int l, int tile) {
    const bf16_t* Z = WSP(bf16_t, WS_Z); bf16_t* Y = WSP(bf16_t, WS_Y);
    LAS float* U = (LAS float*)F.lds;
    const int t0 = tile * 64, s0 = (tile < 256) ? 0 : SEQ, s1 = (tile < 256) ? SEQ : MT;
    {
        const int c8 = (F.tid & 31) * 8, rb = F.tid >> 5;
        u32x4 av[6], gv[6];
#pragma unroll
        for (int i = 0; i < 6; ++i) { const int r = rb + 16 * i, t = t0 - 15 + r; const bool ok = (r < 94) && (t >= s0) && (t < s1);
            av[i] = (u32x4){0u, 0u, 0u, 0u}; gv[i] = av[i];
            if (ok) { av[i] = *(const u32x4*)(Z + (size_t)t * ZLD + ZC_CONF + c8); gv[i] = *(const u32x4*)(Z + (size_t)t * ZLD + ZC_CONF + 256 + c8); } }
#pragma unroll
        for (int i = 0; i < 6; ++i) { const int r = rb + 16 * i; if (r < 94) { const u32x4 a = av[i], g = gv[i]; f32x4 u0, u1;
            u0[0] = bflo(a.x) * sigmoidf_(bflo(g.x)); u0[1] = bfhi(a.x) * sigmoidf_(bfhi(g.x)); u0[2] = bflo(a.y) * sigmoidf_(bflo(g.y)); u0[3] = bfhi(a.y) * sigmoidf_(bfhi(g.y));
            u1[0] = bflo(a.z) * sigmoidf_(bflo(g.z)); u1[1] = bfhi(a.z) * sigmoidf_(bfhi(g.z)); u1[2] = bflo(a.w) * sigmoidf_(bflo(g.w)); u1[3] = bfhi(a.w) * sigmoidf_(bfhi(g.w));
            *(LAS f32x4*)(U + r * 256 + c8) = u0; *(LAS f32x4*)(U + r * 256 + c8 + 4) = u1; } }
    }
    __syncthreads();
    const int c = F.tid & 255, hf = F.tid >> 8;
    float uw[62];
#pragma unroll
    for (int i = 0; i < 62; ++i) uw[i] = U[(hf * 32 + i) * 256 + c];
    __syncthreads();
    float acc[32]; const float bias = F.in[10][l * 256 + c];
#pragma unroll
    for (int t = 0; t < 32; ++t) acc[t] = bias;
    const float* w = F.in[9] + (size_t)l * 31 * 256 + c;
    float wk[31];
#pragma unroll
    for (int k = 0; k < 31; ++k) wk[k] = w[k * 256];
#pragma unroll
    for (int k = 0; k < 31; ++k) {
#pragma unroll
        for (int t = 0; t < 32; ++t) acc[t] += wk[k] * uw[t + k]; }
#pragma unroll
    for (int t = 0; t < 32; ++t) U[(hf * 32 + t) * 256 + c] = acc[t];
    __syncthreads();
    const f32x4 gn = ((const f32x4*)(F.in[11] + l * 256))[F.lane], bn = ((const f32x4*)(F.in[12] + l * 256))[F.lane];
    for (int t = F.wave; t < 64; t += NWAVES) {
        const f32x4 v = *(const LAS f32x4*)(U + t * 256 + 4 * F.lane);
        const float mean = wave_sum((v[0] + v[1]) + (v[2] + v[3])) * (1.f / 256.f);
        const f32x4 d = v - mean;
        const float var = wave_sum((d[0] * d[0] + d[1] * d[1]) + (d[2] * d[2] + d[3] * d[3])) * (1.f / 256.f);
        const float rstd = __builtin_amdgcn_rsqf(var + EPS);
        f32x4 y = d * rstd * gn + bn;
#pragma unroll
        for (int e = 0; e < 4; ++e) y[e] = siluf_(y[e]);
        u32x2 o; o.x = cvtpk(y[0], y[1]); o.y = cvtpk(y[2], y[3]);
        *(u32x2*)(Y + (size_t)(t0 + t) * D + 0 + 4 * F.lane) = o;
    }
    __syncthreads();
}
__device__ __forceinline__ void conv_b_items(Frame& F, int l) {
    const bf16_t* Z = WSP(bf16_t, WS_Z); bf16_t* Y = WSP(bf16_t, WS_Y);
    const float* w = F.in[13] + (size_t)l * 3 * 256;
    const int nrow = (l == 1) ? SEQ : MT;
    for (int idx = F.bid * NTHR + F.tid; idx < nrow * 32; idx += F.G * NTHR) {
        const int t = idx >> 5, c8 = (idx & 31) * 8, s0 = (t < SEQ) ? 0 : SEQ, s1 = (t < SEQ) ? SEQ : MT;
        float acc[8];
#pragma unroll
        for (int e = 0; e < 8; ++e) acc[e] = 0.f;
#pragma unroll
        for (int k = 0; k < 3; ++k) { const int tt = t + k - 1; if (tt < s0 || tt >= s1) continue;
            const u32x4 cg = *(const u32x4*)(Z + (size_t)tt * ZLD + ZC_SC + 256 + c8), xv = *(const u32x4*)(Z + (size_t)tt * ZLD + ZC_SC + 512 + c8);
            const f32x4 w0 = *(const f32x4*)(w + k * 256 + c8), w1 = *(const f32x4*)(w + k * 256 + c8 + 4);
            acc[0] += w0[0] * bflo(cg.x) * bflo(xv.x); acc[1] += w0[1] * bfhi(cg.x) * bfhi(xv.x); acc[2] += w0[2] * bflo(cg.y) * bflo(xv.y); acc[3] += w0[3] * bfhi(cg.y) * bfhi(xv.y);
            acc[4] += w1[0] * bflo(cg.z) * bflo(xv.z); acc[5] += w1[1] * bfhi(cg.z) * bfhi(xv.z); acc[6] += w1[2] * bflo(cg.w) * bflo(xv.w); acc[7] += w1[3] * bfhi(cg.w) * bfhi(xv.w); }
        const u32x4 bg = *(const u32x4*)(Z + (size_t)t * ZLD + ZC_SC + c8);
        u32x4 o; o.x = cvtpk(acc[0] * bflo(bg.x), acc[1] * bfhi(bg.x)); o.y = cvtpk(acc[2] * bflo(bg.y), acc[3] * bfhi(bg.y));
        o.z = cvtpk(acc[4] * bflo(bg.z), acc[5] * bfhi(bg.z)); o.w = cvtpk(acc[6] * bflo(bg.w), acc[7] * bfhi(bg.w));
        *(u32x4*)(Y + (size_t)t * D + 256 + c8) = o;
    }
}
__device__ __forceinline__ void kmax_items(Frame& F, int l) {
    const bf16_t* Z = WSP(bf16_t, WS_Z); unsigned* tab = WSP(unsigned, WS_CTL) + CW_KMAX + l * 260 * 8;
    for (int it = F.gw; it < 260 * 8; it += F.NGW) {
        const int t = it >> 3, hm = it & 7;
        const bf16_t* kr = Z + (size_t)(t * 64 + F.lane) * ZLD + ZC_DK + hm * 32;
        float ss = 0.f;
#pragma unroll
        for (int c = 0; c < 4; ++c) { const u32x4 a = *(const u32x4*)(kr + c * 8);
            ss += bflo(a.x) * bflo(a.x) + bfhi(a.x) * bfhi(a.x) + bflo(a.y) * bflo(a.y) + bfhi(a.y) * bfhi(a.y) + bflo(a.z) * bflo(a.z) + bfhi(a.z) * bfhi(a.z) + bflo(a.w) * bflo(a.w) + bfhi(a.w) * bfhi(a.w); }
        ss = wave_max(ss);
        if (F.lane == 0) { atomicMax(tab + it, __float_as_uint(ss)); atomicMax(WSP(unsigned, WS_CTL) + CW_KMAXG + l * 8 + hm, __float_as_uint(ss)); }
    }
}
__device__ __forceinline__ void ret_kv_unit(Frame& F, int l, int unit) {
    const int n = unit >> 2, h = unit & 3;
    const bf16_t* Z = WSP(bf16_t, WS_Z); float* KV = WSP(float, WS_KV);
    LAS float* ks = (LAS float*)F.lds;
    LAS float* vs = ks + 128 * 32;
    for (int idx = F.tid; idx < 128 * 4; idx += NTHR) { const int j = idx >> 2, c8 = (idx & 3) * 8; const u32x4 a = *(const u32x4*)(Z + (size_t)(n * 128 + j) * ZLD + ZC_RK + h * 32 + c8);
        LAS float* p = ks + j * 32 + c8; p[0] = bflo(a.x); p[1] = bfhi(a.x); p[2] = bflo(a.y); p[3] = bfhi(a.y); p[4] = bflo(a.z); p[5] = bfhi(a.z); p[6] = bflo(a.w); p[7] = bfhi(a.w); }
    for (int idx = F.tid; idx < 128 * 8; idx += NTHR) { const int j = idx >> 3, c8 = (idx & 7) * 8; const u32x4 a = *(const u32x4*)(Z + (size_t)(n * 128 + j) * ZLD + ZC_RV + h * 64 + c8);
        LAS float* p = vs + j * 64 + c8; p[0] = bflo(a.x); p[1] = bfhi(a.x); p[2] = bflo(a.y); p[3] = bfhi(a.y); p[4] = bflo(a.z); p[5] = bfhi(a.z); p[6] = bflo(a.w); p[7] = bfhi(a.w); }
    __syncthreads();
    const int dir = F.wave >> 2, d = F.lane & 31, e0 = (F.wave & 3) * 16 + (F.lane >> 5) * 8;
    const float lg2 = (dir ? F.in[20][l * 4 + h] : F.in[19][l * 4 + h]) * 1.4426950408889634f;
    float acc[8];
#pragma unroll
    for (int e = 0; e < 8; ++e) acc[e] = 0.f;
    for (int j = 0; j < 128; ++j) {
        const float dec = __builtin_amdgcn_exp2f((dir ? (float)j : (float)(127 - j)) * lg2);
        const float kd = ks[j * 32 + d] * dec;
        const f32x4 v0 = *(const LAS f32x4*)(vs + j * 64 + e0), v1 = *(const LAS f32x4*)(vs + j * 64 + e0 + 4);
        acc[0] += kd * v0[0]; acc[1] += kd * v0[1]; acc[2] += kd * v0[2]; acc[3] += kd * v0[3]; acc[4] += kd * v1[0]; acc[5] += kd * v1[1]; acc[6] += kd * v1[2]; acc[7] += kd * v1[3];
    }
    float* o = KV + (((size_t)dir * NCH + n) * 4 + h) * 2048;
#pragma unroll
    for (int e = 0; e < 8; ++e) o[(e0 + e) * 32 + d] = acc[e];
    __syncthreads();
}
__device__ __forceinline__ void scan_publish(Frame& F, int l) {
    if (F.wave == 0) {
        for (int gid = F.bid * 64 + F.lane; gid < 2 * 4 * 2048; gid += F.G * 64) {
            const int dir = gid >> 13, h = (gid >> 11) & 3, idx = gid & 2047;
            const float* KV = WSP(float, WS_KV) + (size_t)dir * NCH * 4 * 2048 + h * 2048 + idx; bf16_t* SS = WSP(bf16_t, WS_SST) + (size_t)dir * NCH * 4 * 2048 + h * 2048 + idx;
            const float dec = expf(128.f * (dir ? F.in[20][l * 4 + h] : F.in[19][l * 4 + h]));
            float S = 0.f;
#pragma unroll 1
            for (int c0 = 0; c0 < NCH; c0 += 65) {
#define SCAN_NN(o_) (dir ? ((o_) == 0 ? 129 : (o_) == 1 ? 128 : NCH - 1 - (o_)) : ((o_) == 0 ? 128 : (o_) == 1 ? 129 : (o_) - 2))
                float kv[65];
#pragma unroll
                for (int c = 0; c < 65; ++c) kv[c] = KV[(size_t)SCAN_NN(c0 + c) * 8192];
#pragma unroll
                for (int c = 0; c < 65; ++c) { SS[(size_t)SCAN_NN(c0 + c) * 8192] = f2bf(S); S = dec * S + kv[c]; }
#undef SCAN_NN
            }
        }
        asm volatile("s_waitcnt vmcnt(0)" ::: "memory");
        if (F.lane == 0) { __builtin_amdgcn_fence(__ATOMIC_RELEASE, "agent"); asm volatile("s_waitcnt vmcnt(0)" ::: "memory");
            __hip_atomic_fetch_add(WSP(unsigned, WS_CTL) + CW_SCAN + l * 64, 1u, __ATOMIC_RELAXED, __HIP_MEMORY_SCOPE_AGENT); }
    }
}
__device__ __forceinline__ void scan_wait(Frame& F, int l) {
    if (F.wave == 0) {
        unsigned* c = WSP(unsigned, WS_CTL) + CW_SCAN + l * 64; unsigned sp = 0;
        while ((unsigned)__builtin_amdgcn_readfirstlane(__hip_atomic_load(c, __ATOMIC_RELAXED, __HIP_MEMORY_SCOPE_AGENT)) < (unsigned)F.G) { __builtin_amdgcn_s_sleep(4); if (++sp > (1u << 22)) break; }
        __builtin_amdgcn_fence(__ATOMIC_ACQUIRE, "agent");
        asm volatile("s_waitcnt vmcnt(0)" ::: "memory");
    }
    __syncthreads();
}

__device__ __forceinline__ float diff_lambda(Frame& F, int l, float lam_init);
namespace att {
typedef short s16x4 __attribute__((ext_vector_type(4)));
typedef short v4i16_t __attribute__((ext_vector_type(4)));
constexpr int SLOTB = 8192, LDS_K = 0, LDS_V = 2 * SLOTB;
constexpr float THR = 12.f;
__device__ __forceinline__ int crow(int r, int hi) { return (r & 3) + 8 * (r >> 2) + 4 * hi; }
__device__ __forceinline__ s16x4 vtr(const LAS unsigned char* p) { return __builtin_bit_cast(s16x4, __builtin_amdgcn_ds_read_tr16_b64_v4i16((LAS v4i16_t*)p)); }
__device__ __forceinline__ float half_max(float m) { auto rr = __builtin_amdgcn_permlane32_swap(__float_as_uint(m), __float_as_uint(m), false, false); return fmaxf(__uint_as_float(rr[0]), __uint_as_float(rr[1])); }
__device__ __forceinline__ float half_sum(float m) { auto rr = __builtin_amdgcn_permlane32_swap(__float_as_uint(m), __float_as_uint(m), false, false); return __uint_as_float(rr[0]) + __uint_as_float(rr[1]); }
__device__ __forceinline__ float sum32(float v) {
    v += dpp_f<0xB1>(v); v += dpp_f<0x4E>(v); v += dpp_f<0x141>(v); v += dpp_f<0x140>(v);
    auto rr = __builtin_amdgcn_permlane16_swap(__float_as_uint(v), __float_as_uint(v), false, false); return __uint_as_float(rr[0]) + __uint_as_float(rr[1]);
}
__device__ __forceinline__ float rowmax32(const f32x16& a, const f32x16& b) {
    float x = fmaxf(fmaxf(a[0], a[1]), b[0]), y = fmaxf(fmaxf(a[2], a[3]), b[1]); x = fmaxf(fmaxf(x, b[2]), b[3]);
#pragma unroll
    for (int r = 4; r < 16; r += 4) { x = fmaxf(fmaxf(x, a[r]), a[r + 1]); y = fmaxf(fmaxf(y, a[r + 2]), a[r + 3]); x = fmaxf(fmaxf(x, b[r]), b[r + 1]); y = fmaxf(fmaxf(y, b[r + 2]), b[r + 3]); }
    return half_max(fmaxf(x, y));
}
__device__ __forceinline__ void softmax_map(f32x16& sa, f32x16& sb, float& m, float& l, f32x16 (&o)[2], u32x4 (&pw)[4], int hi) {
    const float rm = rowmax32(sa, sb);
    if (__builtin_expect(__any(rm - m > THR), 0)) {
        const float mn = fmaxf(m, rm), f = __builtin_amdgcn_exp2f(m - mn); m = mn; l *= f;
        int hi_ = hi; asm volatile("" : "+v"(hi_));
#pragma unroll
        for (int r = 0; r < 16; ++r) { const float fr_ = __int_as_float(__builtin_amdgcn_ds_bpermute(4 * crow(r, hi_), __float_as_int(f))); o[0][r] *= fr_; o[1][r] *= fr_; }
    }
    float sum = 0.f;
#pragma unroll
    for (int r = 0; r < 16; ++r) { sa[r] = __builtin_amdgcn_exp2f(sa[r] - m); sb[r] = __builtin_amdgcn_exp2f(sb[r] - m); sum += sa[r] + sb[r]; }
    l += sum;
    pw[0] = (u32x4){cvtpk(sa[0], sa[1]), cvtpk(sa[2], sa[3]), cvtpk(sa[4], sa[5]), cvtpk(sa[6], sa[7])};
    pw[1] = (u32x4){cvtpk(sa[8], sa[9]), cvtpk(sa[10], sa[11]), cvtpk(sa[12], sa[13]), cvtpk(sa[14], sa[15])};
    pw[2] = (u32x4){cvtpk(sb[0], sb[1]), cvtpk(sb[2], sb[3]), cvtpk(sb[4], sb[5]), cvtpk(sb[6], sb[7])};
    pw[3] = (u32x4){cvtpk(sb[8], sb[9]), cvtpk(sb[10], sb[11]), cvtpk(sb[12], sb[13]), cvtpk(sb[14], sb[15])};
}
__device__ __forceinline__ void attn_unit(Frame& F, int l, int h, int q0, int k0, int nt, float lam, float lam_init) {
    const bf16_t* Z = WSP(bf16_t, WS_Z); bf16_t* Y = WSP(bf16_t, WS_Y);
    const int lane = F.lane, r32 = lane & 31, hi = lane >> 5, wid = F.wave;
    const bf16_t* Qw = Z + (size_t)(q0 + wid * 32) * ZLD + ZC_DQ + h * 64;
    const bf16_t* ksrc = Z + (size_t)(k0 + lane) * ZLD + ZC_DK + h * 64 + wid * 8;
    const bf16_t* vsrc = Z + (size_t)(k0 + 16 * (wid & 3) + (lane >> 2)) * ZLD + ZC_DV + h * 64 + (wid >> 2) * 32 + (lane & 3) * 8;
    LAS unsigned char* lds = F.lds;
    const unsigned lds0 = (unsigned)(size_t)lds;
#define ATT_GLDS(gsrc, dst) do { unsigned keep_; asm volatile("s_mov_b32 %0, m0\n\ts_mov_b32 m0, %2\n\ts_nop 0\n\tglobal_load_lds_dwordx4 %1, off\n\ts_mov_b32 m0, %0" : "=&s"(keep_) : "v"(gsrc), "s"(dst) : "memory"); } while (0)
#define ATT_DMA(t, slot) do { ATT_GLDS(ksrc + (size_t)(t) * 64 * ZLD, (unsigned)__builtin_amdgcn_readfirstlane(lds0 + LDS_K + (slot) * SLOTB + wid * 1024)); \
        ATT_GLDS(vsrc + (size_t)(t) * 64 * ZLD, (unsigned)__builtin_amdgcn_readfirstlane(lds0 + LDS_V + (slot) * SLOTB + wid * 1024)); } while (0)
    __syncthreads();
    ATT_DMA(0, 0);
    bf16x8 qr[4];
#pragma unroll
    for (int d0 = 0; d0 < 4; ++d0) qr[d0] = *(const bf16x8*)(Qw + (size_t)r32 * ZLD + d0 * 16 + hi * 8);
    f32x16 o1[2], o2[2];
#pragma unroll
    for (int r = 0; r < 16; ++r) { o1[0][r] = 0.f; o1[1][r] = 0.f; o2[0][r] = 0.f; o2[1][r] = 0.f; }
    float m1 = 0.f, m2 = 0.f, l1 = 0.f, l2 = 0.f;
    const int kfo = hi * 1024 + r32 * 16;
    const int vfo = ((lane >> 4) & 1) * 32 + (lane & 3) * 8 + (4 * hi + ((lane & 15) >> 2)) * 64;
    asm volatile("s_waitcnt vmcnt(0)" ::: "memory");
    __syncthreads();
    for (int t = 0; t < nt; ++t) {
        const int cur = t & 1;
        const LAS unsigned char* kp = lds + LDS_K + cur * SLOTB + kfo;
        const LAS unsigned char* vp = lds + LDS_V + cur * SLOTB + vfo;
        if (t + 1 < nt) ATT_DMA(t + 1, cur ^ 1);
        const f32x16 zero = {0.f, 0.f, 0.f, 0.f, 0.f, 0.f, 0.f, 0.f, 0.f, 0.f, 0.f, 0.f, 0.f, 0.f, 0.f, 0.f};
        u32x4 pw[4];
        bf16x8 kf[4];
#pragma unroll
        for (int d0 = 0; d0 < 2; ++d0) { kf[2 * d0] = *(const LAS bf16x8*)(kp + d0 * 2048); kf[2 * d0 + 1] = *(const LAS bf16x8*)(kp + d0 * 2048 + 512); }
        f32x16 sa = __builtin_amdgcn_mfma_f32_32x32x16_bf16(kf[0], qr[0], zero, 0, 0, 0); sa = __builtin_amdgcn_mfma_f32_32x32x16_bf16(kf[2], qr[1], sa, 0, 0, 0);
        f32x16 sb = __builtin_amdgcn_mfma_f32_32x32x16_bf16(kf[1], qr[0], zero, 0, 0, 0); sb = __builtin_amdgcn_mfma_f32_32x32x16_bf16(kf[3], qr[1], sb, 0, 0, 0);
#pragma unroll
        for (int d0 = 0; d0 < 2; ++d0) { kf[2 * d0] = *(const LAS bf16x8*)(kp + 4096 + d0 * 2048); kf[2 * d0 + 1] = *(const LAS bf16x8*)(kp + 4096 + d0 * 2048 + 512); }
        f32x16 ta = __builtin_amdgcn_mfma_f32_32x32x16_bf16(kf[0], qr[2], zero, 0, 0, 0); ta = __builtin_amdgcn_mfma_f32_32x32x16_bf16(kf[2], qr[3], ta, 0, 0, 0);
        f32x16 tb = __builtin_amdgcn_mfma_f32_32x32x16_bf16(kf[1], qr[2], zero, 0, 0, 0); tb = __builtin_amdgcn_mfma_f32_32x32x16_bf16(kf[3], qr[3], tb, 0, 0, 0);
        softmax_map(sa, sb, m1, l1, o1, pw, hi);
        bf16x8 vf[2][4];
#pragma unroll
        for (int d0 = 0; d0 < 2; ++d0)
#pragma unroll
            for (int ks = 0; ks < 4; ++ks) { const s16x4 lo = vtr(vp + d0 * 4096 + ks * 1024), hh = vtr(vp + d0 * 4096 + ks * 1024 + 512);
                vf[d0][ks] = (bf16x8){lo[0], lo[1], lo[2], lo[3], hh[0], hh[1], hh[2], hh[3]}; }
#pragma unroll
        for (int d0 = 0; d0 < 2; ++d0)
#pragma unroll
            for (int ks = 0; ks < 4; ++ks) o1[d0] = __builtin_amdgcn_mfma_f32_32x32x16_bf16(__builtin_bit_cast(bf16x8, pw[ks]), vf[d0][ks], o1[d0], 0, 0, 0);
        softmax_map(ta, tb, m2, l2, o2, pw, hi);
#pragma unroll
        for (int d0 = 0; d0 < 2; ++d0)
#pragma unroll
            for (int ks = 0; ks < 4; ++ks) o2[d0] = __builtin_amdgcn_mfma_f32_32x32x16_bf16(__builtin_bit_cast(bf16x8, pw[ks]), vf[d0][ks], o2[d0], 0, 0, 0);
        asm volatile("s_waitcnt vmcnt(0)" ::: "memory");
        __syncthreads();
    }
#undef ATT_GLDS
#undef ATT_DMA
    l1 = half_sum(l1); l2 = half_sum(l2);
    const float i1 = __builtin_amdgcn_rcpf(l1), i2 = lam * __builtin_amdgcn_rcpf(l2);
    int lane_ = lane; asm volatile("" : "+v"(lane_));
    const int r32e = lane_ & 31, hie = lane_ >> 5;
    const float g0 = F.in[18][l * 64 + r32e] * (1.f - lam_init), g1 = F.in[18][l * 64 + 32 + r32e] * (1.f - lam_init);
#pragma unroll
    for (int r = 0; r < 16; ++r) {
        const int qi = crow(r, hie);
        const float a = __int_as_float(__builtin_amdgcn_ds_bpermute(4 * qi, __float_as_int(i1))), b = __int_as_float(__builtin_amdgcn_ds_bpermute(4 * qi, __float_as_int(i2)));
        const float x0 = o1[0][r] * a - o2[0][r] * b, x1 = o1[1][r] * a - o2[1][r] * b;
        const float ss = sum32(x0 * x0 + x1 * x1);
        const float rs = __builtin_amdgcn_rsqf(ss * (1.f / 64.f) + EPS);
        bf16_t* yp = Y + (size_t)(q0 + wid * 32 + qi) * D + 512 + h * 64 + r32e;
        yp[0] = f2bf(x0 * rs * g0); yp[32] = f2bf(x1 * rs * g1);
    }
}
#ifndef ATT_VARIANT
#define ATT_VARIANT 0
#endif
#ifndef ATT_STAGGER
#define ATT_STAGGER 5
#endif
constexpr int SUBT = 4;
constexpr float THR2 = 40.f;
__device__ __forceinline__ void fast_map(f32x16& sa, f32x16& sb, float& l, u32x4 (&pw)[4]) {
    float sum = 0.f;
#pragma unroll
    for (int r = 0; r < 16; ++r) { sa[r] = __builtin_amdgcn_exp2f(sa[r]); sb[r] = __builtin_amdgcn_exp2f(sb[r]); sum += sa[r] + sb[r]; }
    l += sum;
    pw[0] = (u32x4){cvtpk(sa[0], sa[1]), cvtpk(sa[2], sa[3]), cvtpk(sa[4], sa[5]), cvtpk(sa[6], sa[7])};
    pw[1] = (u32x4){cvtpk(sa[8], sa[9]), cvtpk(sa[10], sa[11]), cvtpk(sa[12], sa[13]), cvtpk(sa[14], sa[15])};
    pw[2] = (u32x4){cvtpk(sb[0], sb[1]), cvtpk(sb[2], sb[3]), cvtpk(sb[4], sb[5]), cvtpk(sb[6], sb[7])};
    pw[3] = (u32x4){cvtpk(sb[8], sb[9]), cvtpk(sb[10], sb[11]), cvtpk(sb[12], sb[13]), cvtpk(sb[14], sb[15])};
}
template <bool FAST> __device__ __forceinline__ void attn_body2(Frame& F, int l, int h, int q0, int k0, int nt, float lam, float lam_init, int lane, const bf16x8 (&qr)[4]) {
    const bf16_t* Z = WSP(bf16_t, WS_Z); bf16_t* Y = WSP(bf16_t, WS_Y);
    const int r32 = lane & 31, hi = lane >> 5, wid = F.wave;
    const unsigned koff = (unsigned)(((k0 + 8 * wid + (lane & 7)) * ZLD + ZC_DK + h * 64 + (lane >> 3) * 8) * 2);
    const unsigned voff = (unsigned)(((k0 + 16 * (wid & 3) + (lane >> 2)) * ZLD + ZC_DV + h * 64 + (wid >> 2) * 32 + (lane & 3) * 8) * 2);
    LAS unsigned char* lds = F.lds;
    const unsigned lds0 = (unsigned)(size_t)lds;
#define ATT_GLDS2(voff_, sbase_, m0b_, imm_) do { unsigned keep_; asm volatile("s_mov_b32 %0, m0\n\ts_add_i32 m0, %3, %4\n\ts_nop 0\n\tglobal_load_lds_dwordx4 %1, %2\n\ts_mov_b32 m0, %0" \
        : "=&s"(keep_) : "v"(voff_), "s"(sbase_), "s"(m0b_), "n"(imm_) : "memory", "scc"); } while (0)
    const unsigned m0w = (unsigned)__builtin_amdgcn_readfirstlane(lds0 + wid * 1024);
#define ATT_DMA2(it_, slot) do { const unsigned m0s_ = m0w + (unsigned)(slot) * (SUBT * 16384); const char* zb_ = (const char*)Z + (size_t)(it_) * (SUBT * 64 * ZLD * 2); \
        _Pragma("unroll") for (int j_ = 0; j_ < SUBT; ++j_) { const char* zj_ = zb_ + (size_t)j_ * (64 * ZLD * 2); \
        ATT_GLDS2(koff, zj_, m0s_, j_ * 8192); ATT_GLDS2(voff, zj_, m0s_, SUBT * 8192 + j_ * 8192); } } while (0)
    __syncthreads();
    ATT_DMA2(0, 0);
    f32x16 o1[2], o2[2];
#pragma unroll
    for (int r = 0; r < 16; ++r) { o1[0][r] = 0.f; o1[1][r] = 0.f; o2[0][r] = 0.f; o2[1][r] = 0.f; }
    float m1 = FAST ? 0.f : -1e30f, m2 = m1, l1 = 0.f, l2 = 0.f;
    const int kfo = (r32 >> 3) * 1024 + hi * 128 + (r32 & 7) * 16;
    const int vfo = ((lane >> 4) & 1) * 32 + (lane & 3) * 8 + (4 * hi + ((lane & 15) >> 2)) * 64;
    asm volatile("s_waitcnt vmcnt(0)" ::: "memory");
    __syncthreads();
    const int nit = nt / SUBT;
    for (int it = 0; it < nit; ++it) {
        const int cur = it & 1;
        if (it + 1 < nit) ATT_DMA2(it + 1, cur ^ 1);
#pragma unroll 1
        for (int j = 0; j < SUBT; ++j) {
            const LAS unsigned char* kp = lds + cur * (SUBT * 16384) + j * 8192 + kfo;
            const LAS unsigned char* vp = lds + cur * (SUBT * 16384) + SUBT * 8192 + j * 8192 + vfo;
            const f32x16 zero = {0.f, 0.f, 0.f, 0.f, 0.f, 0.f, 0.f, 0.f, 0.f, 0.f, 0.f, 0.f, 0.f, 0.f, 0.f, 0.f};
            u32x4 pw[4];
            bf16x8 kf[4];
#pragma unroll
            for (int d0 = 0; d0 < 2; ++d0) { kf[2 * d0] = *(const LAS bf16x8*)(kp + d0 * 256); kf[2 * d0 + 1] = *(const LAS bf16x8*)(kp + d0 * 256 + 4096); }
            f32x16 sa = __builtin_amdgcn_mfma_f32_32x32x16_bf16(kf[0], qr[0], zero, 0, 0, 0); sa = __builtin_amdgcn_mfma_f32_32x32x16_bf16(kf[2], qr[1], sa, 0, 0, 0);
            f32x16 sb = __builtin_amdgcn_mfma_f32_32x32x16_bf16(kf[1], qr[0], zero, 0, 0, 0); sb = __builtin_amdgcn_mfma_f32_32x32x16_bf16(kf[3], qr[1], sb, 0, 0, 0);
#pragma unroll
            for (int d0 = 0; d0 < 2; ++d0) { kf[2 * d0] = *(const LAS bf16x8*)(kp + 512 + d0 * 256); kf[2 * d0 + 1] = *(const LAS bf16x8*)(kp + 512 + d0 * 256 + 4096); }
            f32x16 ta = __builtin_amdgcn_mfma_f32_32x32x16_bf16(kf[0], qr[2], zero, 0, 0, 0); ta = __builtin_amdgcn_mfma_f32_32x32x16_bf16(kf[2], qr[3], ta, 0, 0, 0);
            f32x16 tb = __builtin_amdgcn_mfma_f32_32x32x16_bf16(kf[1], qr[2], zero, 0, 0, 0); tb = __builtin_amdgcn_mfma_f32_32x32x16_bf16(kf[3], qr[3], tb, 0, 0, 0);
            if constexpr (FAST) fast_map(sa, sb, l1, pw); else softmax_map(sa, sb, m1, l1, o1, pw, hi);
            bf16x8 vf[2][4];
#pragma unroll
            for (int d0 = 0; d0 < 2; ++d0)
#pragma unroll
                for (int ks = 0; ks < 4; ++ks) { const s16x4 lo = vtr(vp + d0 * 4096 + ks * 1024), hh = vtr(vp + d0 * 4096 + ks * 1024 + 512);
                    vf[d0][ks] = (bf16x8){lo[0], lo[1], lo[2], lo[3], hh[0], hh[1], hh[2], hh[3]}; }
#pragma unroll
            for (int d0 = 0; d0 < 2; ++d0)
#pragma unroll
                for (int ks = 0; ks < 4; ++ks) o1[d0] = __builtin_amdgcn_mfma_f32_32x32x16_bf16(__builtin_bit_cast(bf16x8, pw[ks]), vf[d0][ks], o1[d0], 0, 0, 0);
            if constexpr (FAST) fast_map(ta, tb, l2, pw); else softmax_map(ta, tb, m2, l2, o2, pw, hi);
#pragma unroll
            for (int d0 = 0; d0 < 2; ++d0)
#pragma unroll
                for (int ks = 0; ks < 4; ++ks) o2[d0] = __builtin_amdgcn_mfma_f32_32x32x16_bf16(__builtin_bit_cast(bf16x8, pw[ks]), vf[d0][ks], o2[d0], 0, 0, 0);
        }
        asm volatile("s_waitcnt vmcnt(0)" ::: "memory");
        __syncthreads();
    }
#undef ATT_GLDS2
#undef ATT_DMA2
    l1 = half_sum(l1); l2 = half_sum(l2);
    { int lz_ = __builtin_amdgcn_readfirstlane(l); asm volatile("" : "+s"(lz_)); lam_init = (lz_ == 0) ? 0.2f : (0.8f - 0.6f * 0.7408182206817179f); lam = diff_lambda(F, lz_, lam_init); }
    const float i1 = __builtin_amdgcn_rcpf(l1), i2 = lam * __builtin_amdgcn_rcpf(l2);
    int lane_; asm volatile("v_mbcnt_lo_u32_b32 %0, -1, 0\n\tv_mbcnt_hi_u32_b32 %0, -1, %0" : "=v"(lane_));
    const int r32e = lane_ & 31, hie = lane_ >> 5;
    const float g0 = F.in[18][l * 64 + r32e] * (1.f - lam_init), g1 = F.in[18][l * 64 + 32 + r32e] * (1.f - lam_init);
#pragma unroll
    for (int r = 0; r < 16; ++r) {
        const int qi = crow(r, hie);
        const float a = __int_as_float(__builtin_amdgcn_ds_bpermute(4 * qi, __float_as_int(i1))), b = __int_as_float(__builtin_amdgcn_ds_bpermute(4 * qi, __float_as_int(i2)));
        const float x0 = o1[0][r] * a - o2[0][r] * b, x1 = o1[1][r] * a - o2[1][r] * b;
        const float ss = sum32(x0 * x0 + x1 * x1);
        const float rs = __builtin_amdgcn_rsqf(ss * (1.f / 64.f) + EPS);
        bf16_t* yp = Y + (size_t)(q0 + wid * 32 + qi) * D + 512 + h * 64 + r32e;
        yp[0] = f2bf(x0 * rs * g0); yp[32] = f2bf(x1 * rs * g1);
    }
}
template <int VAR> __device__ __forceinline__ void attn_body3(Frame& F, int l, int h, int q0, int k0, int nt, float lam, float lam_init, int lane, const bf16x8 (&qr)[4], bf16_t* Y) {
    const bf16_t* Z = WSP(bf16_t, WS_Z);
    const int r32 = lane & 31, hi = lane >> 5, wid = F.wave;
#define KOFF(ln_) ((unsigned)(((k0 + 8 * wid + ((ln_) & 7)) * ZLD + ZC_DK + h * 64 + ((ln_) >> 3) * 8) * 2))
#define VOFF(ln_) ((unsigned)(((k0 + 16 * (wid & 3) + ((ln_) >> 2)) * ZLD + ZC_DV + h * 64 + (wid >> 2) * 32 + ((ln_) & 3) * 8) * 2))
    LAS unsigned char* lds = F.lds;
    const unsigned lds0 = (unsigned)(size_t)lds;
#define ATT_GLDS2(voff_, sbase_, m0b_, imm_) do { unsigned keep_; asm volatile("s_mov_b32 %0, m0\n\ts_add_i32 m0, %3, %4\n\ts_nop 0\n\tglobal_load_lds_dwordx4 %1, %2\n\ts_mov_b32 m0, %0" \
        : "=&s"(keep_) : "v"(voff_), "s"(sbase_), "s"(m0b_), "n"(imm_) : "memory", "scc"); } while (0)
    const unsigned m0w = (unsigned)__builtin_amdgcn_readfirstlane(lds0 + wid * 1024);
#define ATT_DMA2(it_, slot) do { int ln_ = lane; asm volatile("" : "+v"(ln_)); const unsigned koff = KOFF(ln_), voff = VOFF(ln_); const unsigned m0s_ = m0w + (unsigned)(slot) * (SUBT * 16384); const char* zb_ = (const char*)Z + (size_t)(it_) * (SUBT * 64 * ZLD * 2); \
        _Pragma("unroll") for (int j_ = 0; j_ < SUBT; ++j_) { const char* zj_ = zb_ + (size_t)j_ * (64 * ZLD * 2); \
        ATT_GLDS2(koff, zj_, m0s_, j_ * 8192); ATT_GLDS2(voff, zj_, m0s_, SUBT * 8192 + j_ * 8192); } } while (0)
    __syncthreads();
    ATT_DMA2(0, 0);
    f32x16 o1[2], o2[2], pA0, pA1, pB0, pB1;
#pragma unroll
    for (int r = 0; r < 16; ++r) { o1[0][r] = 0.f; o1[1][r] = 0.f; o2[0][r] = 0.f; o2[1][r] = 0.f; pB0[r] = 0.f; pB1[r] = 0.f; }
    float l1 = 0.f, l2 = 0.f;
    bf16x8 vf[2][4];
#pragma unroll
    for (int d0 = 0; d0 < 2; ++d0)
#pragma unroll
        for (int ks = 0; ks < 4; ++ks) vf[d0][ks] = (bf16x8){0, 0, 0, 0, 0, 0, 0, 0};
    asm volatile("s_waitcnt vmcnt(0)" ::: "memory");
    __syncthreads();
    const int nit = nt / SUBT;
    const f32x16 zero = {0.f, 0.f, 0.f, 0.f, 0.f, 0.f, 0.f, 0.f, 0.f, 0.f, 0.f, 0.f, 0.f, 0.f, 0.f, 0.f};
    bf16x8 kf[4];
#define SBAR() __builtin_amdgcn_sched_barrier(0)
#define FADD(acc_, x_) asm("v_add_f32_e32 %0, %1, %0" : "+v"(acc_) : "v"(x_))
#define EX(v) ((VAR == 1) ? (v) : __builtin_amdgcn_exp2f(v))
#define PVM(acc_, a_, b_) ((VAR == 2) ? (acc_) : __builtin_amdgcn_mfma_f32_32x32x16_bf16(a_, b_, acc_, 0, 0, 0))
#define KLOAD(kp_) do { kf[0] = *(const LAS bf16x8*)(kp_); kf[1] = *(const LAS bf16x8*)((kp_) + 4096); kf[2] = *(const LAS bf16x8*)((kp_) + 256); kf[3] = *(const LAS bf16x8*)((kp_) + 4352); } while (0)
#define VRD(d0_, ks_) do { if (VAR == 4) break; const s16x4 lo_ = vtr(vp_ + (d0_) * 4096 + (ks_) * 1024), hh_ = vtr(vp_ + (d0_) * 4096 + (ks_) * 1024 + 512); \
        vf[d0_][ks_] = (bf16x8){lo_[0], lo_[1], lo_[2], lo_[3], hh_[0], hh_[1], hh_[2], hh_[3]}; } while (0)
#define ADD8I(s0_, s1_, s2_, s3_, a0_, a1_, a2_, a3_, b0_, b1_, b2_, b3_, c0_, c1_, c2_, c3_) asm("v_add_f32_e32 %0, %4, %8\n\tv_add_f32_e32 %1, %5, %9\n\tv_add_f32_e32 %2, %6, %10\n\tv_add_f32_e32 %3, %7, %11\n\t" \
        "v_add_f32_e32 %0, %12, %0\n\tv_add_f32_e32 %1, %13, %1\n\tv_add_f32_e32 %2, %14, %2\n\tv_add_f32_e32 %3, %15, %3" : "=&v"(s0_), "=&v"(s1_), "=&v"(s2_), "=&v"(s3_) \
        : "v"(a0_), "v"(a1_), "v"(a2_), "v"(a3_), "v"(b0_), "v"(b1_), "v"(b2_), "v"(b3_), "v"(c0_), "v"(c1_), "v"(c2_), "v"(c3_))
#define ADD8(s0_, s1_, s2_, s3_, a0_, a1_, a2_, a3_, b0_, b1_, b2_, b3_) asm("v_add_f32_e32 %0, %4, %0\n\tv_add_f32_e32 %1, %5, %1\n\tv_add_f32_e32 %2, %6, %2\n\tv_add_f32_e32 %3, %7, %3\n\t" \
        "v_add_f32_e32 %0, %8, %0\n\tv_add_f32_e32 %1, %9, %1\n\tv_add_f32_e32 %2, %10, %2\n\tv_add_f32_e32 %3, %11, %3" : "+v"(s0_), "+v"(s1_), "+v"(s2_), "+v"(s3_) \
        : "v"(a0_), "v"(a1_), "v"(a2_), "v"(a3_), "v"(b0_), "v"(b1_), "v"(b2_), "v"(b3_))
#define ADD8F(s0_, s1_, s2_, s3_, a0_, a1_, a2_, a3_, lp_) asm("v_add_f32_e32 %0, %5, %0\n\tv_add_f32_e32 %1, %6, %1\n\tv_add_f32_e32 %2, %7, %2\n\tv_add_f32_e32 %3, %8, %3\n\t" \
        "v_add_f32_e32 %0, %1, %0\n\tv_add_f32_e32 %2, %3, %2\n\tv_add_f32_e32 %0, %2, %0\n\tv_add_f32_e32 %4, %0, %4" : "+v"(s0_), "+v"(s1_), "+v"(s2_), "+v"(s3_), "+v"(lp_) \
        : "v"(a0_), "v"(a1_), "v"(a2_), "v"(a3_))
#define STEP(C0, C1, P0, P1, QA, QB, OP, LP, VL, KNP, KN) do { \
        float s0_, s1_, s2_, s3_; u32x4 pwa_, pwb_; \
        C0 = __builtin_amdgcn_mfma_f32_32x32x16_bf16(kf[0], QA, zero, 0, 0, 0); SBAR(); \
        ADD8I(s0_, s1_, s2_, s3_, P0[0], P0[1], P0[2], P0[3], P0[4], P0[5], P0[6], P0[7], P0[8], P0[9], P0[10], P0[11]); \
        if (VL) { VRD(0, 0); VRD(1, 0); VRD(0, 1); VRD(1, 1); } SBAR(); \
        C0 = __builtin_amdgcn_mfma_f32_32x32x16_bf16(kf[2], QB, C0, 0, 0, 0); SBAR(); \
        ADD8(s0_, s1_, s2_, s3_, P0[12], P0[13], P0[14], P0[15], P1[0], P1[1], P1[2], P1[3]); \
        if (VL) { VRD(0, 2); VRD(1, 2); VRD(0, 3); VRD(1, 3); } SBAR(); \
        C1 = __builtin_amdgcn_mfma_f32_32x32x16_bf16(kf[1], QA, zero, 0, 0, 0); SBAR(); \
        ADD8(s0_, s1_, s2_, s3_, P1[4], P1[5], P1[6], P1[7], P1[8], P1[9], P1[10], P1[11]); \
        SBAR(); \
        C1 = __builtin_amdgcn_mfma_f32_32x32x16_bf16(kf[3], QB, C1, 0, 0, 0); SBAR(); \
        pwa_ = (u32x4){cvtpk(P0[0], P0[1]), cvtpk(P0[2], P0[3]), cvtpk(P0[4], P0[5]), cvtpk(P0[6], P0[7])}; SBAR(); \
        ADD8F(s0_, s1_, s2_, s3_, P1[12], P1[13], P1[14], P1[15], LP); SBAR(); \
        pwb_.x = cvtpk(P0[8], P0[9]); pwb_.y = cvtpk(P0[10], P0[11]); SBAR(); \
        OP[0] = PVM(OP[0], __builtin_bit_cast(bf16x8, pwa_), vf[0][0]); C0[0] = EX(C0[0]); C0[1] = EX(C0[1]); C0[2] = EX(C0[2]); C0[3] = EX(C0[3]); \
        if (KN) KLOAD(KNP); SBAR(); \
        OP[1] = PVM(OP[1], __builtin_bit_cast(bf16x8, pwa_), vf[1][0]); pwb_.z = cvtpk(P0[12], P0[13]); pwb_.w = cvtpk(P0[14], P0[15]); SBAR(); C0[4] = EX(C0[4]); C0[5] = EX(C0[5]); C0[6] = EX(C0[6]); C0[7] = EX(C0[7]); \
        SBAR(); \
        OP[0] = PVM(OP[0], __builtin_bit_cast(bf16x8, pwb_), vf[0][1]); pwa_.x = cvtpk(P1[0], P1[1]); pwa_.y = cvtpk(P1[2], P1[3]); SBAR(); C0[8] = EX(C0[8]); C0[9] = EX(C0[9]); C0[10] = EX(C0[10]); C0[11] = EX(C0[11]); \
        SBAR(); \
        OP[1] = PVM(OP[1], __builtin_bit_cast(bf16x8, pwb_), vf[1][1]); pwa_.z = cvtpk(P1[4], P1[5]); pwa_.w = cvtpk(P1[6], P1[7]); SBAR(); C0[12] = EX(C0[12]); C0[13] = EX(C0[13]); C0[14] = EX(C0[14]); C0[15] = EX(C0[15]); \
        SBAR(); \
        OP[0] = PVM(OP[0], __builtin_bit_cast(bf16x8, pwa_), vf[0][2]); pwb_.x = cvtpk(P1[8], P1[9]); pwb_.y = cvtpk(P1[10], P1[11]); SBAR(); C1[0] = EX(C1[0]); C1[1] = EX(C1[1]); C1[2] = EX(C1[2]); C1[3] = EX(C1[3]); \
        SBAR(); \
        OP[1] = PVM(OP[1], __builtin_bit_cast(bf16x8, pwa_), vf[1][2]); pwb_.z = cvtpk(P1[12], P1[13]); pwb_.w = cvtpk(P1[14], P1[15]); SBAR(); C1[4] = EX(C1[4]); C1[5] = EX(C1[5]); C1[6] = EX(C1[6]); C1[7] = EX(C1[7]); \
        SBAR(); \
        OP[0] = PVM(OP[0], __builtin_bit_cast(bf16x8, pwb_), vf[0][3]); C1[8] = EX(C1[8]); C1[9] = EX(C1[9]); C1[10] = EX(C1[10]); C1[11] = EX(C1[11]); SBAR(); \
        OP[1] = PVM(OP[1], __builtin_bit_cast(bf16x8, pwb_), vf[1][3]); C1[12] = EX(C1[12]); C1[13] = EX(C1[13]); C1[14] = EX(C1[14]); C1[15] = EX(C1[15]); SBAR(); \
    } while (0)
    if (wid >= 4) __builtin_amdgcn_s_setprio(1);
    for (int it = 0; it < nit; ++it) {
        const int cur = it & 1;
        if (it + 1 < nit) ATT_DMA2(it + 1, cur ^ 1);
        int ln2_; asm volatile("v_mbcnt_lo_u32_b32 %0, -1, 0\n\tv_mbcnt_hi_u32_b32 %0, -1, %0" : "=v"(ln2_));
        const int kfo = ((ln2_ & 31) >> 3) * 1024 + (ln2_ >> 5) * 128 + (ln2_ & 7) * 16;
        const int vfo = ((ln2_ >> 4) & 1) * 32 + (ln2_ & 3) * 8 + (4 * (ln2_ >> 5) + ((ln2_ & 15) >> 2)) * 64;
        const LAS unsigned char* kb = lds + cur * (SUBT * 16384) + kfo;
        const LAS unsigned char* vb = lds + cur * (SUBT * 16384) + SUBT * 8192 + vfo;
        KLOAD(kb);
#pragma unroll
        for (int j = 0; j < SUBT; ++j) {
            const LAS unsigned char* kp = kb + j * 8192;
            const LAS unsigned char* vp_ = vb + j * 8192;
            STEP(pA0, pA1, pB0, pB1, qr[0], qr[1], o2, l2, false, kp + 512, true);
            STEP(pB0, pB1, pA0, pA1, qr[2], qr[3], o1, l1, true, kp + 8192, (j + 1 < SUBT));
        }
        asm volatile("s_waitcnt vmcnt(0)" ::: "memory");
        __syncthreads();
    }
    __builtin_amdgcn_s_setprio(0);
    {
        float sacc_ = 0.f;
#pragma unroll
        for (int r = 0; r < 16; ++r) sacc_ += pB0[r] + pB1[r];
        l2 += sacc_;
        u32x4 pw0, pw1, pw2, pw3;
        pw0 = (u32x4){cvtpk(pB0[0], pB0[1]), cvtpk(pB0[2], pB0[3]), cvtpk(pB0[4], pB0[5]), cvtpk(pB0[6], pB0[7])};
        pw1 = (u32x4){cvtpk(pB0[8], pB0[9]), cvtpk(pB0[10], pB0[11]), cvtpk(pB0[12], pB0[13]), cvtpk(pB0[14], pB0[15])};
        pw2 = (u32x4){cvtpk(pB1[0], pB1[1]), cvtpk(pB1[2], pB1[3]), cvtpk(pB1[4], pB1[5]), cvtpk(pB1[6], pB1[7])};
        pw3 = (u32x4){cvtpk(pB1[8], pB1[9]), cvtpk(pB1[10], pB1[11]), cvtpk(pB1[12], pB1[13]), cvtpk(pB1[14], pB1[15])};
#pragma unroll
        for (int d0 = 0; d0 < 2; ++d0) {
            o2[d0] = __builtin_amdgcn_mfma_f32_32x32x16_bf16(__builtin_bit_cast(bf16x8, pw0), vf[d0][0], o2[d0], 0, 0, 0);
            o2[d0] = __builtin_amdgcn_mfma_f32_32x32x16_bf16(__builtin_bit_cast(bf16x8, pw1), vf[d0][1], o2[d0], 0, 0, 0);
            o2[d0] = __builtin_amdgcn_mfma_f32_32x32x16_bf16(__builtin_bit_cast(bf16x8, pw2), vf[d0][2], o2[d0], 0, 0, 0);
            o2[d0] = __builtin_amdgcn_mfma_f32_32x32x16_bf16(__builtin_bit_cast(bf16x8, pw3), vf[d0][3], o2[d0], 0, 0, 0);
        }
    }
#undef STEP
#undef VRD
#undef KLOAD
#undef EX
#undef PVM
#undef FADD
#undef ADD8I
#undef ADD8
#undef ADD8F
#undef SBAR
#undef ATT_GLDS2
#undef ATT_DMA2
#undef KOFF
#undef VOFF
    l1 = half_sum(l1); l2 = half_sum(l2);
    { int lz_ = __builtin_amdgcn_readfirstlane(l); asm volatile("" : "+s"(lz_)); lam_init = (lz_ == 0) ? 0.2f : (0.8f - 0.6f * 0.7408182206817179f); lam = diff_lambda(F, lz_, lam_init); }
    const float i1 = __builtin_amdgcn_rcpf(l1), i2 = lam * __builtin_amdgcn_rcpf(l2);
    int lane_; asm volatile("v_mbcnt_lo_u32_b32 %0, -1, 0\n\tv_mbcnt_hi_u32_b32 %0, -1, %0" : "=v"(lane_));
    const int r32e = lane_ & 31, hie = lane_ >> 5;
    const float g0 = F.in[18][l * 64 + r32e] * (1.f - lam_init), g1 = F.in[18][l * 64 + 32 + r32e] * (1.f - lam_init);
#pragma unroll
    for (int r = 0; r < 16; ++r) {
        const int qi = crow(r, hie);
        const float a = __int_as_float(__builtin_amdgcn_ds_bpermute(4 * qi, __float_as_int(i1))), b = __int_as_float(__builtin_amdgcn_ds_bpermute(4 * qi, __float_as_int(i2)));
        const float x0 = o1[0][r] * a - o2[0][r] * b, x1 = o1[1][r] * a - o2[1][r] * b;
        const float ss = sum32(x0 * x0 + x1 * x1);
        const float rs = __builtin_amdgcn_rsqf(ss * (1.f / 64.f) + EPS);
        bf16_t* yp = Y + (size_t)(q0 + wid * 32 + qi) * D + 512 + h * 64 + r32e;
        yp[0] = f2bf(x0 * rs * g0); yp[32] = f2bf(x1 * rs * g1);
    }
}
__device__ __forceinline__ void attn_unit2(Frame& F, int l, int h, int q0, int k0, int nt, float lam, float lam_init, bool isdup) {
    const bf16_t* Z = WSP(bf16_t, WS_Z);
    int lane; asm volatile("v_mbcnt_lo_u32_b32 %0, -1, 0\n\tv_mbcnt_hi_u32_b32 %0, -1, %0" : "=v"(lane));
    const int r32 = lane & 31, hi = lane >> 5;
    const bf16_t* Qw = Z + (size_t)(q0 + F.wave * 32) * ZLD + ZC_DQ + h * 64;
    bf16x8 qr[4];
#pragma unroll
    for (int d0 = 0; d0 < 4; ++d0) qr[d0] = *(const bf16x8*)(Qw + (size_t)r32 * ZLD + d0 * 16 + hi * 8);
    float q21 = 0.f, q22 = 0.f;
#pragma unroll
    for (int j = 0; j < 8; ++j) { const float a = bf2f((bf16_t)qr[0][j]), b = bf2f((bf16_t)qr[1][j]), c = bf2f((bf16_t)qr[2][j]), d = bf2f((bf16_t)qr[3][j]); q21 += a * a + b * b; q22 += c * c + d * d; }
    const float* kg = (const float*)(WSP(unsigned, WS_CTL) + CW_KMAXG + l * 8 + h * 2);
    const float k1 = kg[0], k2 = kg[1];
    const bool safe = (2.f * q21 * k1 <= THR2 * THR2) && (2.f * q22 * k2 <= THR2 * THR2);
#if DUP_KIND == 4
    if (__all(safe)) { if (isdup) attn_body3<ATT_VARIANT>(F, l, h, q0, k0, nt, lam, lam_init, lane, qr, WSP(bf16_t, WS_H)); else attn_body2<true>(F, l, h, q0, k0, nt, lam, lam_init, lane, qr); }
#else
    if (__all(safe)) attn_body3<0>(F, l, h, q0, k0, nt, lam, lam_init, lane, qr, WSP(bf16_t, WS_Y));
#endif
    else attn_body2<false>(F, l, h, q0, k0, nt, lam, lam_init, lane, qr);
}
__device__ __forceinline__ void ret_unit(Frame& F, int l, int n, int hp) {
    const bf16_t* Z = WSP(bf16_t, WS_Z); bf16_t* Y = WSP(bf16_t, WS_Y); const bf16_t* SS = WSP(bf16_t, WS_SST);
    int lane; asm volatile("v_mbcnt_lo_u32_b32 %0, -1, 0\n\tv_mbcnt_hi_u32_b32 %0, -1, %0" : "=v"(lane));
    int wid = F.wave; asm volatile("" : "+s"(wid));
    const int r32 = lane & 31, hi = lane >> 5, hs = wid >> 2, wq = wid & 3, h = 2 * hp + hs;
    LAS unsigned char* lds = F.lds + hs * 24576;
    const unsigned lds0 = (unsigned)(size_t)lds;
#define RET_GLDS2(voff_, sbase_, m0b_, imm_) do { unsigned keep_; asm volatile("s_mov_b32 %0, m0\n\ts_add_i32 m0, %3, %4\n\ts_nop 0\n\tglobal_load_lds_dwordx4 %1, %2\n\ts_mov_b32 m0, %0" \
        : "=&s"(keep_) : "v"(voff_), "s"(sbase_), "s"(m0b_), "n"(imm_) : "memory", "scc"); } while (0)
    __syncthreads();
    const size_t t0 = (size_t)n * 128;
    {
        const char* zb = (const char*)(Z + t0 * ZLD);
        const unsigned m0k = (unsigned)__builtin_amdgcn_readfirstlane(lds0 + wq * 2048), m0v = (unsigned)__builtin_amdgcn_readfirstlane(lds0 + 8192 + wq * 2048);
        const unsigned kof = (unsigned)((lane * ZLD + ZC_RK + h * 32 + wq * 8) * 2);
        const unsigned vof = (unsigned)(((wq * 32 + (lane >> 2)) * ZLD + ZC_RV + h * 64 + (lane & 3) * 8) * 2);
        RET_GLDS2(kof, zb, m0k, 0); RET_GLDS2(kof, zb + (size_t)64 * ZLD * 2, m0k, 1024);
        RET_GLDS2(vof, zb, m0v, 0); RET_GLDS2(vof, zb + (size_t)16 * ZLD * 2, m0v, 1024);
        RET_GLDS2(vof, zb + 64, m0v, 8192); RET_GLDS2(vof, zb + (size_t)16 * ZLD * 2 + 64, m0v, 8192 + 1024);
    }
    const float lf = F.in[19][l * 4 + h] * 1.4426950408889634f, lb = F.in[20][l * 4 + h] * 1.4426950408889634f;
    const int qi = wq * 32 + r32;
    u32x4 qf[2];
#pragma unroll
    for (int s_ = 0; s_ < 2; ++s_) qf[s_] = *(const u32x4*)(Z + (t0 + qi) * ZLD + ZC_RQ + h * 32 + s_ * 16 + hi * 8);
    const float dqf = __builtin_amdgcn_exp2f((float)(qi + 1) * lf), dqb = __builtin_amdgcn_exp2f((float)(128 - qi) * lb);
    f32x16 o[2];
#pragma unroll
    for (int r = 0; r < 16; ++r) { o[0][r] = 0.f; o[1][r] = 0.f; }
    {
        const bf16_t* sf = SS + (((size_t)0 * NCH + n) * 4 + h) * 2048; const bf16_t* sb = SS + (((size_t)1 * NCH + n) * 4 + h) * 2048;
#pragma unroll
        for (int s_ = 0; s_ < 2; ++s_) {
            const u32x4 q = qf[s_];
            u32x4 qa, qb;
            qa.x = cvtpk(bflo(q.x) * dqf, bfhi(q.x) * dqf); qa.y = cvtpk(bflo(q.y) * dqf, bfhi(q.y) * dqf); qa.z = cvtpk(bflo(q.z) * dqf, bfhi(q.z) * dqf); qa.w = cvtpk(bflo(q.w) * dqf, bfhi(q.w) * dqf);
            qb.x = cvtpk(bflo(q.x) * dqb, bfhi(q.x) * dqb); qb.y = cvtpk(bflo(q.y) * dqb, bfhi(q.y) * dqb); qb.z = cvtpk(bflo(q.z) * dqb, bfhi(q.z) * dqb); qb.w = cvtpk(bflo(q.w) * dqb, bfhi(q.w) * dqb);
#pragma unroll
            for (int dh = 0; dh < 2; ++dh) {
                const bf16x8 bf_ = *(const bf16x8*)(sf + (dh * 32 + r32) * 32 + s_ * 16 + hi * 8), bb_ = *(const bf16x8*)(sb + (dh * 32 + r32) * 32 + s_ * 16 + hi * 8);
                o[dh] = __builtin_amdgcn_mfma_f32_32x32x16_bf16(__builtin_bit_cast(bf16x8, qa), bf_, o[dh], 0, 0, 0);
                o[dh] = __builtin_amdgcn_mfma_f32_32x32x16_bf16(__builtin_bit_cast(bf16x8, qb), bb_, o[dh], 0, 0, 0);
            }
        }
    }
    asm volatile("s_waitcnt vmcnt(0)" ::: "memory");
    __syncthreads();
    const LAS unsigned char* kp = lds + hi * 2048 + r32 * 16;
    const LAS unsigned char* vp = lds + 8192 + ((lane >> 4) & 1) * 32 + (lane & 3) * 8 + (4 * hi + ((lane & 15) >> 2)) * 64;
    const f32x16 zero = {0.f, 0.f, 0.f, 0.f, 0.f, 0.f, 0.f, 0.f, 0.f, 0.f, 0.f, 0.f, 0.f, 0.f, 0.f, 0.f};
#pragma unroll
    for (int kb = 0; kb < 4; ++kb) {
        const bf16x8 k0_ = *(const LAS bf16x8*)(kp + 0 * 2048 + kb * 512), k1_ = *(const LAS bf16x8*)(kp + 2 * 2048 + kb * 512);
        f32x16 sc = __builtin_amdgcn_mfma_f32_32x32x16_bf16(k0_, __builtin_bit_cast(bf16x8, qf[0]), zero, 0, 0, 0);
        sc = __builtin_amdgcn_mfma_f32_32x32x16_bf16(k1_, __builtin_bit_cast(bf16x8, qf[1]), sc, 0, 0, 0);
#pragma unroll
        for (int r = 0; r < 16; ++r) { const int dd = qi - (kb * 32 + crow(r, hi));
            const float fac = (dd > 0) ? __builtin_amdgcn_exp2f((float)dd * lf) : (dd < 0) ? __builtin_amdgcn_exp2f((float)(-dd) * lb) : 2.f;
            sc[r] *= fac; }
        u32x4 pw[2];
        pw[0] = (u32x4){cvtpk(sc[0], sc[1]), cvtpk(sc[2], sc[3]), cvtpk(sc[4], sc[5]), cvtpk(sc[6], sc[7])};
        pw[1] = (u32x4){cvtpk(sc[8], sc[9]), cvtpk(sc[10], sc[11]), cvtpk(sc[12], sc[13]), cvtpk(sc[14], sc[15])};
#pragma unroll
        for (int s_ = 0; s_ < 2; ++s_) { const int ks = 2 * kb + s_;
#pragma unroll
            for (int dh = 0; dh < 2; ++dh) { const s16x4 lo = vtr(vp + dh * 8192 + ks * 1024), hh = vtr(vp + dh * 8192 + ks * 1024 + 512);
                const bf16x8 vf = (bf16x8){lo[0], lo[1], lo[2], lo[3], hh[0], hh[1], hh[2], hh[3]};
                o[dh] = __builtin_amdgcn_mfma_f32_32x32x16_bf16(__builtin_bit_cast(bf16x8, pw[s_]), vf, o[dh], 0, 0, 0); } }
    }
#undef RET_GLDS2
    int lane_ = lane; asm volatile("" : "+v"(lane_));
    const int r32e = lane_ & 31, hie = lane_ >> 5;
    bf16_t gq[16][2];
#pragma unroll
    for (int r = 0; r < 16; ++r) { const bf16_t* gp = Z + (t0 + wq * 32 + crow(r, hie)) * ZLD + ZC_RG + h * 64 + r32e; gq[r][0] = gp[0]; gq[r][1] = gp[32]; }
#pragma unroll
    for (int r = 0; r < 16; ++r) {
        const size_t tok = t0 + wq * 32 + crow(r, hie);
        const float mean = sum32(o[0][r] + o[1][r]) * (1.f / 64.f);
        const float d0_ = o[0][r] - mean, d1_ = o[1][r] - mean;
        const float rstd = __builtin_amdgcn_rsqf(sum32(d0_ * d0_ + d1_ * d1_) * (1.f / 64.f) + EPS);
        bf16_t* yp = Y + tok * D + 768 + h * 64 + r32e;
        yp[0] = f2bf(siluf_(bf2f(gq[r][0])) * d0_ * rstd); yp[32] = f2bf(siluf_(bf2f(gq[r][1])) * d1_ * rstd);
    }
}
}

__device__ __forceinline__ float diff_lambda(Frame& F, int l, float lam_init) {
    float a = 0.f, b = 0.f;
    for (int i = 0; i < 32; ++i) { a += F.in[14][l * 32 + i] * F.in[15][l * 32 + i]; b += F.in[16][l * 32 + i] * F.in[17][l * 32 + i]; }
    return expf(a) - expf(b) + lam_init;
}
__device__ __forceinline__ void naive_attn_item(Frame& F, int l, int item, float lam, float lam_init) {
    const bf16_t* Z = WSP(bf16_t, WS_Z); bf16_t* Y = WSP(bf16_t, WS_Y);
    int h, q, k0, k1; const int mp = F.tid & 1;
    if (item < 256) { h = item & 3; q = (item >> 2) * 256 + (F.tid >> 1); k0 = 0; k1 = MT; }
    else { h = item - 256; q = SEQ + (F.tid >> 1); k0 = SEQ; k1 = MT; }
    float qv[32], o[64];
#pragma unroll
    for (int i = 0; i < 4; ++i) { const u32x4 a = *(const u32x4*)(Z + (size_t)q * ZLD + ZC_DQ + h * 64 + mp * 32 + i * 8);
        qv[i * 8 + 0] = bflo(a.x); qv[i * 8 + 1] = bfhi(a.x); qv[i * 8 + 2] = bflo(a.y); qv[i * 8 + 3] = bfhi(a.y); qv[i * 8 + 4] = bflo(a.z); qv[i * 8 + 5] = bfhi(a.z); qv[i * 8 + 6] = bflo(a.w); qv[i * 8 + 7] = bfhi(a.w); }
#pragma unroll
    for (int e = 0; e < 64; ++e) o[e] = 0.f;
    float m1 = -1e30f, l1 = 0.f;
    for (int j = k0; j < k1; ++j) {
        const bf16_t* kr = Z + (size_t)j * ZLD + ZC_DK + h * 64 + mp * 32; const bf16_t* vr = Z + (size_t)j * ZLD + ZC_DV + h * 64;
        float s1 = 0.f;
#pragma unroll
        for (int i = 0; i < 4; ++i) { const u32x4 a = *(const u32x4*)(kr + i * 8);
            s1 += qv[i * 8 + 0] * bflo(a.x) + qv[i * 8 + 1] * bfhi(a.x) + qv[i * 8 + 2] * bflo(a.y) + qv[i * 8 + 3] * bfhi(a.y) + qv[i * 8 + 4] * bflo(a.z) + qv[i * 8 + 5] * bfhi(a.z) + qv[i * 8 + 6] * bflo(a.w) + qv[i * 8 + 7] * bfhi(a.w); }
        if (s1 > m1) { const float f = __builtin_amdgcn_exp2f(m1 - s1); l1 *= f;
#pragma unroll
            for (int e = 0; e < 64; ++e) o[e] *= f;
            m1 = s1; }
        const float p1 = __builtin_amdgcn_exp2f(s1 - m1); l1 += p1;
#pragma unroll
        for (int i = 0; i < 8; ++i) { const u32x4 a = *(const u32x4*)(vr + i * 8);
            o[i * 8 + 0] += p1 * bflo(a.x); o[i * 8 + 1] += p1 * bfhi(a.x); o[i * 8 + 2] += p1 * bflo(a.y); o[i * 8 + 3] += p1 * bfhi(a.y); o[i * 8 + 4] += p1 * bflo(a.z); o[i * 8 + 5] += p1 * bfhi(a.z); o[i * 8 + 6] += p1 * bflo(a.w); o[i * 8 + 7] += p1 * bfhi(a.w); }
        asm volatile("" ::: "memory");
    }
    const float sc = mp ? (-lam / l1) : (1.f / l1); float ss = 0.f;
#pragma unroll
    for (int e = 0; e < 64; ++e) { o[e] *= sc; o[e] += xor1_f(o[e]); ss += o[e] * o[e]; }
    const float rs = __builtin_amdgcn_rsqf(ss * (1.f / 64.f) + EPS) * (1.f - lam_init);
#pragma unroll
    for (int i = 0; i < 8; ++i) { const float* g = F.in[18] + l * 64 + i * 8;
        u32x4 w; w.x = cvtpk(o[i * 8 + 0] * rs * g[0], o[i * 8 + 1] * rs * g[1]); w.y = cvtpk(o[i * 8 + 2] * rs * g[2], o[i * 8 + 3] * rs * g[3]);
        w.z = cvtpk(o[i * 8 + 4] * rs * g[4], o[i * 8 + 5] * rs * g[5]); w.w = cvtpk(o[i * 8 + 6] * rs * g[6], o[i * 8 + 7] * rs * g[7]);
        if ((i >> 2) == mp) *(u32x4*)(Y + (size_t)q * D + 512 + h * 64 + i * 8) = w; }
}
__device__ __forceinline__ void naive_ret_item(Frame& F, int l, int n) {
    const bf16_t* Z = WSP(bf16_t, WS_Z); bf16_t* Y = WSP(bf16_t, WS_Y); const bf16_t* SS = WSP(bf16_t, WS_SST);
    const int h = F.tid >> 7, i = F.tid & 127, tok = n * 128 + i;
    const float lf = F.in[19][l * 4 + h] * 1.4426950408889634f, lb = F.in[20][l * 4 + h] * 1.4426950408889634f;
    float q[32], o[64];
#pragma unroll
    for (int c = 0; c < 4; ++c) { const u32x4 a = *(const u32x4*)(Z + (size_t)tok * ZLD + ZC_RQ + h * 32 + c * 8);
        q[c * 8 + 0] = bflo(a.x); q[c * 8 + 1] = bfhi(a.x); q[c * 8 + 2] = bflo(a.y); q[c * 8 + 3] = bfhi(a.y); q[c * 8 + 4] = bflo(a.z); q[c * 8 + 5] = bfhi(a.z); q[c * 8 + 6] = bflo(a.w); q[c * 8 + 7] = bfhi(a.w); }
#pragma unroll
    for (int e = 0; e < 64; ++e) o[e] = 0.f;
    for (int j = 0; j < 128; ++j) {
        const bf16_t* kr = Z + (size_t)(n * 128 + j) * ZLD + ZC_RK + h * 32; const bf16_t* vr = Z + (size_t)(n * 128 + j) * ZLD + ZC_RV + h * 64;
        float s = 0.f;
#pragma unroll
        for (int c = 0; c < 4; ++c) { const u32x4 a = *(const u32x4*)(kr + c * 8);
            s += q[c * 8 + 0] * bflo(a.x) + q[c * 8 + 1] * bfhi(a.x) + q[c * 8 + 2] * bflo(a.y) + q[c * 8 + 3] * bfhi(a.y) + q[c * 8 + 4] * bflo(a.z) + q[c * 8 + 5] * bfhi(a.z) + q[c * 8 + 6] * bflo(a.w) + q[c * 8 + 7] * bfhi(a.w); }
        const float fac = (i > j) ? __builtin_amdgcn_exp2f((float)(i - j) * lf) : (i < j) ? __builtin_amdgcn_exp2f((float)(j - i) * lb) : 2.f;
        s *= fac;
#pragma unroll
        for (int c = 0; c < 8; ++c) { const u32x4 a = *(const u32x4*)(vr + c * 8);
            o[c * 8 + 0] += s * bflo(a.x); o[c * 8 + 1] += s * bfhi(a.x); o[c * 8 + 2] += s * bflo(a.y); o[c * 8 + 3] += s * bfhi(a.y); o[c * 8 + 4] += s * bflo(a.z); o[c * 8 + 5] += s * bfhi(a.z); o[c * 8 + 6] += s * bflo(a.w); o[c * 8 + 7] += s * bfhi(a.w); }
    }
    const float qf = __builtin_amdgcn_exp2f((float)(i + 1) * lf), qb = __builtin_amdgcn_exp2f((float)(128 - i) * lb);
    {
        LAS float* Sl = (LAS float*)F.lds;
        __syncthreads();
        for (int idx = F.tid; idx < 16384; idx += NTHR) { const int hh = idx >> 12, dir = (idx >> 11) & 1, e = (idx >> 5) & 63, d = idx & 31;
            Sl[(hh * 2 + dir) * 2048 + d * 64 + e] = bf2f(SS[(((size_t)dir * NCH + n) * 4 + hh) * 2048 + e * 32 + d]); }
        __syncthreads();
        const bf16_t* qrow = Z + (size_t)tok * ZLD + ZC_RQ + h * 32;
        for (int d = 0; d < 32; ++d) {
            const float qd = bf2f(qrow[d]), a = qd * qf, b = qd * qb;
            const LAS float* sf = Sl + (h * 2 + 0) * 2048 + d * 64; const LAS float* sb = Sl + (h * 2 + 1) * 2048 + d * 64;
#pragma unroll
            for (int e = 0; e < 64; ++e) o[e] += a * sf[e] + b * sb[e];
        }
    }
    float mean = 0.f;
#pragma unroll
    for (int e = 0; e < 64; ++e) mean += o[e];
    mean *= (1.f / 64.f); float var = 0.f;
#pragma unroll
    for (int e = 0; e < 64; ++e) { o[e] -= mean; var += o[e] * o[e]; }
    const float rstd = __builtin_amdgcn_rsqf(var * (1.f / 64.f) + EPS);
#pragma unroll
    for (int c = 0; c < 8; ++c) { const u32x4 g = *(const u32x4*)(Z + (size_t)tok * ZLD + ZC_RG + h * 64 + c * 8);
        u32x4 w; w.x = cvtpk(siluf_(bflo(g.x)) * o[c * 8 + 0] * rstd, siluf_(bfhi(g.x)) * o[c * 8 + 1] * rstd); w.y = cvtpk(siluf_(bflo(g.y)) * o[c * 8 + 2] * rstd, siluf_(bfhi(g.y)) * o[c * 8 + 3] * rstd);
        w.z = cvtpk(siluf_(bflo(g.z)) * o[c * 8 + 4] * rstd, siluf_(bfhi(g.z)) * o[c * 8 + 5] * rstd); w.w = cvtpk(siluf_(bflo(g.w)) * o[c * 8 + 6] * rstd, siluf_(bfhi(g.w)) * o[c * 8 + 7] * rstd);
        *(u32x4*)(Y + (size_t)tok * D + 768 + h * 64 + c * 8) = w; }
}

__device__ __forceinline__ int deal_item(int k, int bid, int G, int n, int skip) {
    const int full = n / G, rem = n - full * G;
    if (k < full) return k * G + bid;
    if (k == full) { const int j = G - 1 - skip - bid; if (j >= 0 && j < rem) return full * G + j; }
    return -1;
}
constexpr int LDS_BYTES = 147456;
constexpr int NPL = 7, LASTP = 1 + 2 * NPL, NPHASE = LASTP + 1;
#ifndef DUP_PART
#define DUP_PART 0
#endif
#ifndef DUP_KIND
#define DUP_KIND -1
#endif
__global__ void __launch_bounds__(NTHR, 2) mk_fwd(Args args) {
    extern __shared__ __attribute__((aligned(16))) unsigned char lds_raw[];
    Frame F;
    F.lds = (LAS unsigned char*)lds_raw;
    const int wave_s = __builtin_amdgcn_readfirstlane(threadIdx.x >> 6);
    const int lo = args.ph_lo, hi = args.ph_hi;
#if MK_ONE_LAUNCH
    cg::grid_group grid = cg::this_grid();
    volatile LAS unsigned* bst = (volatile LAS unsigned*)(F.lds + LDS_BYTES - 16);
    unsigned* gbar = (unsigned*)(args.ws + WS_CTL) + CW_BAR;
    if (threadIdx.x == 0) { bst[0] = 0u; bst[1] = 0u; (void)xb_add(&gbar[XB_XCNT(xb_xcc_id())], 1u); }
    __syncthreads();
#endif
#ifndef SKIPMASK
#define SKIPMASK 0
#endif
#define EN(j) (!((SKIPMASK >> (j)) & 1))
    for (int ph = lo; ph < hi; ++ph) {
        { int z_; asm volatile("s_mov_b32 %0, 0" : "=s"(z_)); F.in = args.in + z_; F.out = args.out + z_; F.ws = args.ws + z_;
          F.wave = wave_s + z_; F.G = (int)gridDim.x + z_; F.bid = (int)blockIdx.x + z_; F.NGW = F.G * NWAVES; F.gw = F.bid * NWAVES + F.wave; }
#define FRESH() do { int l_; asm volatile("v_mbcnt_lo_u32_b32 %0, -1, 0\n\tv_mbcnt_hi_u32_b32 %0, -1, %0" : "=v"(l_)); F.lane = l_; F.tid = F.wave * 64 + l_; } while (0)
#ifndef DUP_KIND
#define DUP_KIND -1
#endif
#define KIND_OF(idx_) ((idx_) + ((idx_) >= 3 ? 1 : 0) + ((idx_) >= 5 ? 1 : 0) + ((idx_) >= 6 ? 1 : 0))
#define POS_OF(k_) ((k_) - ((k_) > 3 ? 1 : 0) - ((k_) > 8 ? 1 : 0))
        int po = ph;
        if (DUP_KIND == 20) { po = ph > 0 ? ph - 1 : 0; }
        else if (DUP_KIND == 21) { po = ph > LASTP ? LASTP : ph; }
        else if (DUP_KIND >= 0) { if (po > 1 + NPL + POS_OF(DUP_KIND) + 1) po -= 2; else if (po > 1 + POS_OF(DUP_KIND)) po -= 1; }
#if DUP_KIND >= 0
        const bool isdup = (DUP_KIND == 21) ? (ph == LASTP + 1) : (DUP_KIND == 20) ? false : (ph == 1 + POS_OF(DUP_KIND) + 1 || ph == 1 + NPL + POS_OF(DUP_KIND) + 2);
#else
        constexpr bool isdup = false;
#endif
        const int pos_ = __builtin_amdgcn_readfirstlane(po);
        int l = __builtin_amdgcn_readfirstlane((pos_ >= 1 + NPL) ? 1 : 0); asm volatile("" : "+s"(l));
        int kind = __builtin_amdgcn_readfirstlane((pos_ == 0) ? -1 : (pos_ == LASTP) ? 11 : KIND_OF(pos_ - 1 - NPL * l)); asm volatile("" : "+s"(kind));
        const float lam_init = (l == 0) ? 0.2f : (0.8f - 0.6f * 0.7408182206817179f);
        const bool last = (l == 1);
        const float* modv = WSP(float, WS_MODV) + (size_t)l * 2 * 6144;
        if (kind == -1) { FRESH(); mod_items(F); rope_table(F); }
        else if (kind == 0 && EN(0)) { FRESH(); norm1_phase(F, l, isdup); convert_weights(F, l, 0); }
        else if (kind == 1 && EN(1)) {
            FRESH();
            pg8::Gemm g{WSP(bf16_t, WS_H), WSP(bf16_t, WS_WIN), D, D, D};
            pg8::DenseOrder S{MT / 256, NIN / 256, F.G, F.bid, D, D};
            pg8::EpiIn E{WSP(bf16_t, WS_Z), WSP(bf16_t, WS_G), F.in[22] + (size_t)l * GLD, WSP(float, WS_ROPE)};
            pg8::gemm_phase(F.lds, F.tid, g, S, E);
        }
        else if (kind == 2 && EN(2)) {
            FRESH();
            const bool cvt_first = ((F.bid >> 3) & 1) != 0;
#pragma unroll 1
            for (int pass = 0; pass < 2; ++pass) {
                if ((pass == 0) == cvt_first) { if (!isdup) convert_weights(F, l, 1); }
                else {
                    if (!isdup || DUP_PART == 0 || DUP_PART == 1) for (int k = 0, t; (t = deal_item(k, F.bid, F.G, last ? 256 : 260, 0)) >= 0; ++k) conv_a_tile(F, l, t);
                    if (!isdup || DUP_PART == 0 || DUP_PART == 2) { conv_b_items(F, l); kmax_items(F, l); }
                    if (!isdup || DUP_PART == 0 || DUP_PART == 3) for (int k = 0, u; (u = deal_item(k, F.bid, F.G, NCH * 4, last ? 0 : 4)) >= 0; ++k) ret_kv_unit(F, l, u);
                }
                __syncthreads();
            }
        }
        else if (kind == 4 && EN(4)) {
            FRESH();
            const float lam = 0.f;
            const int nitems = last ? 256 : 260;
            if (!isdup) scan_publish(F, l);
#if MK_NAIVE_ATTN
            for (int it = F.bid; it < nitems; it += F.G) naive_attn_item(F, l, it, lam, lam_init);
#else
            if (!isdup || DUP_PART != 2) for (int u = F.bid; u < nitems; u += F.G) {
                if (u < 256) att::attn_unit2(F, l, (u & 7) >> 1, ((u >> 3) * 2 + (u & 1)) * 256, 0, MT / 64, lam, lam_init, isdup);
                else att::attn_unit2(F, l, u - 256, SEQ, SEQ, CTXL / 64, lam, lam_init, isdup);
            }
            __syncthreads();
#endif
#if MK_NAIVE_RET
            if (!isdup || DUP_PART != 1) for (int n = F.bid; n < (last ? 128 : NCH); n += F.G) naive_ret_item(F, l, n);
#else
            scan_wait(F, l);
            if (!isdup || DUP_PART != 1) for (int k = 0, u; (u = deal_item(k, F.bid, F.G, last ? 256 : 2 * NCH, 0)) >= 0; ++k) att::ret_unit(F, l, u >> 1, u & 1);
            __syncthreads();
#endif
        }
        else if (kind == 5 && EN(5)) {
            FRESH();
            unsigned* mcnt = WSP(unsigned, WS_CTL) + CW_MDONE + l * 80 * 64;
            {
                pg8::Gemm g{WSP(bf16_t, WS_Y), WSP(bf16_t, WS_WB), D, 256, 256};
                pg8::MergeOrder S{mcnt, last ? SEQ / 256 : MT / 256, F.G, F.bid};
                pg8::EpiMerge E{WSP(bf16_t, WS_G), WSP(bf16_t, WS_H)};
                pg8::gemm_phase(F.lds, F.tid, g, S, E);
            }
            {
                pg8::Gemm g{WSP(bf16_t, WS_H), WSP(bf16_t, WS_WO), D, D, D};
                pg8::WoOrder S{last ? SEQ / 256 : MT / 256, F.G, F.bid, mcnt};
                pg8::EpiWo E{l == 0 ? F.in[0] : F.out, F.out, F.in[2], WSP(float, WS_XC), modv + 2 * D, modv + 6144 + 2 * D};
                pg8::gemm_phase(F.lds, F.tid, g, S, E);
            }
        }
        else if (kind == 7 && EN(7)) {
            FRESH();
            const bool cvt_first = ((F.bid >> 3) & 1) != 0;
#pragma unroll 1
            for (int pass = 0; pass < 2; ++pass) {
                if ((pass == 0) == cvt_first) { if (!isdup) convert_weights(F, l, 2); }
                else route_phase(F, l, isdup);
                __syncthreads();
            }
        }
        else if (kind == 9 && EN(9)) {
            FRESH();
            LAS int* tbl = (LAS int*)(F.lds + 131072);
            const int nblk = pg8::moe_table(tbl, WSP(unsigned, WS_CTL) + CW_CNT + l * 2048, F.tid);
            if (F.bid == 0 && F.tid < NE) WSP(int, WS_META)[256 + F.tid] = tbl[160 + F.tid];
            unsigned* dcnt = WSP(unsigned, WS_CTL) + CW_E1DONE + l * 160 * 64;
            {
                pg8::Gemm g{WSP(bf16_t, WS_H), WSP(bf16_t, WS_W13), D, D, D};
                pg8::MoeOrderT<true> S{tbl, nblk * 4, F.G, F.bid, D, D, WSP(unsigned short, WS_INV), dcnt};
                pg8::EpiE1 E{WSP(bf16_t, WS_G + (size_t)CAP * D * 2)};
                pg8::gemm_phase(F.lds, F.tid, g, S, E);
            }
            {
                pg8::Gemm g{WSP(bf16_t, WS_G + (size_t)CAP * D * 2), WSP(bf16_t, WS_W2), FFE, FFE, FFE};
                pg8::MoeOrderT<false> S{tbl, nblk * 4, F.G, F.bid, FFE, FFE, nullptr, dcnt};
                pg8::EpiE2 E{WSP(bf16_t, WS_Z)};
                pg8::gemm_phase(F.lds, F.tid, g, S, E);
            }
        }
        else if (kind == 11) { FRESH(); final_phase(F, isdup); }
#if MK_ONE_LAUNCH
        if (ph + 1 < hi) { if (ph == lo) grid.sync(); else { FRESH(); xcd_barrier(gbar, bst, F.tid, (unsigned)F.G); } }
#endif
    }
}

extern "C" void kernel_launch(void* const* d_in, const int* in_sizes, int n_in, void* d_out, int out_size, void* d_ws, size_t ws_size, hipStream_t stream) {
    static int grid = 0;
    if (grid == 0) {
        if (n_in != 31 || out_size != SEQ * D || ws_size < WS_END) { fprintf(stderr, "kernel_launch: unexpected sizes n_in %d out %d ws %zu (need %zu)\n", n_in, out_size, ws_size, (size_t)WS_END); grid = -1; return; }
        int dev = 0, cus = 0, per_cu = 0;
        (void)hipGetDevice(&dev); (void)hipDeviceGetAttribute(&cus, hipDeviceAttributeMultiprocessorCount, dev);
        (void)hipFuncSetAttribute((const void*)mk_fwd, hipFuncAttributeMaxDynamicSharedMemorySize, LDS_BYTES);
        (void)hipOccupancyMaxActiveBlocksPerMultiprocessor(&per_cu, (const void*)mk_fwd, NTHR, LDS_BYTES);
        if (per_cu < 1) { fprintf(stderr, "kernel_launch: occupancy query says %d blocks/CU\n", per_cu); per_cu = 1; }
        grid = cus;
        (void)hipGetLastError();
    }
    if (grid < 0) return;
    (void)hipMemsetAsync((char*)d_ws + WS_CTL, 0, CTL_ZERO_BYTES, stream);
    Args a{};
    for (int i = 0; i < 31; ++i) a.in[i] = (const float*)d_in[i];
    a.out = (float*)d_out; a.ws = (unsigned char*)d_ws;
#if MK_ONE_LAUNCH
    a.ph_lo = 0; a.ph_hi = NPHASE + (DUP_KIND >= 20 ? 1 : DUP_KIND >= 0 ? 2 : 0);
    void* kargs[] = {&a};
    hipError_t e = hipLaunchCooperativeKernel((const void*)mk_fwd, dim3(grid), dim3(NTHR), kargs, LDS_BYTES, stream);
    if (e != hipSuccess) fprintf(stderr, "cooperative launch failed: %s (grid %d)\n", hipGetErrorString(e), grid);
#else
    for (int p = 0; p < NPHASE; ++p) { a.ph_lo = p; a.ph_hi = p + 1; hipLaunchKernelGGL(mk_fwd, dim3(grid), dim3(NTHR), LDS_BYTES, stream, a); }
#endif
}
```

```cpp
#include <hip/hip_runtime.h>
#include <hip/hip_cooperative_groups.h>
#include <cstdio>
#include <cstdint>
namespace cg = cooperative_groups;

#ifndef DUP_KIND
#define DUP_KIND -1
#endif
#ifndef MK_ONE_LAUNCH
#define MK_ONE_LAUNCH 1
#endif
#ifndef MK_NAIVE_ATTN
#define MK_NAIVE_ATTN 0
#endif
#ifndef MK_NAIVE_RET
#define MK_NAIVE_RET 0
#endif

#define LAS __attribute__((address_space(3)))
typedef unsigned short bf16_t;
typedef short bf16x8 __attribute__((ext_vector_type(8)));
typedef float f32x4 __attribute__((ext_vector_type(4)));
typedef int i32x4 __attribute__((ext_vector_type(4)));
typedef int i32x8 __attribute__((ext_vector_type(8)));
typedef float f32x2 __attribute__((ext_vector_type(2)));
typedef float f32x16 __attribute__((ext_vector_type(16)));
typedef unsigned u32x4 __attribute__((ext_vector_type(4)));
typedef unsigned u32x2 __attribute__((ext_vector_type(2)));
typedef __bf16 bf16x2_t __attribute__((ext_vector_type(2)));

constexpr int D = 1024, SEQ = 16384, CTXL = 256, MT = SEQ + CTXL;
constexpr int ZLD = 2816, GLD = 4096, NIN = ZLD + GLD;
constexpr int ZC_CONF = 0, ZC_SC = 512, ZC_DQ = 1280, ZC_DK = 1536, ZC_DV = 1792, ZC_RQ = 2048, ZC_RK = 2176, ZC_RV = 2304, ZC_RG = 2560;
constexpr int NE = 16, FFE = 512, CAP = 37376, NCH = MT / 128;
constexpr float EPS = 1e-6f;
constexpr float QSCALE = 0.17677669529663687f * 1.4426950408889634f;
constexpr float RKSCALE = 0.17677669529663687f;
constexpr int NTHR = 512, NWAVES = 8;

constexpr size_t MiB = 1u << 20;
constexpr size_t WS_CTL = 0, CTL_ZERO_BYTES = 384 * 1024;
constexpr size_t WS_MODV = 1 * MiB;
constexpr size_t WS_ROPE = WS_MODV + 128 * 1024;
constexpr size_t WS_META = WS_ROPE + 32 * 1024;
constexpr size_t WS_INV = WS_META + 64 * 1024;
constexpr size_t WS_XC = 2 * MiB;
constexpr size_t WS_ROUTE = 3 * MiB;
constexpr size_t WS_WIN = 4 * MiB;
constexpr size_t WS_WB = WS_WIN + (size_t)NIN * D * 2;
constexpr size_t WS_WO = WS_WB + 2 * MiB;
constexpr size_t WS_W13 = WS_WO + 2 * MiB;
constexpr size_t WS_W2 = WS_W13 + 32 * MiB;
constexpr size_t WS_H = 70 * MiB;
constexpr size_t WS_Z = 103 * MiB;
constexpr size_t WS_G = 193 * MiB;
constexpr size_t WS_Y = 323 * MiB;
constexpr size_t WS_H8 = WS_Y + 1 * MiB;
constexpr size_t WS_HS = WS_Y + 20 * MiB;
constexpr size_t WS_MODP = WS_Y;
constexpr size_t WS_KV = 356 * MiB;
constexpr size_t WS_SST = WS_KV + 8 * MiB + 512 * 1024;
constexpr size_t WS_H2I = WS_Z + (size_t)CAP * D * 2;
constexpr size_t WS_HSS = WS_KV;
constexpr size_t WS_END = 369 * MiB;
static_assert(WS_W2 + 16 * MiB <= WS_H && WS_H + (size_t)MT * D * 2 <= WS_Z && WS_Z + (size_t)MT * ZLD * 2 <= WS_G && WS_G + (size_t)MT * GLD * 2 <= WS_Y, "ws map");
static_assert(WS_Y + (size_t)MT * D * 2 <= WS_KV && (size_t)2 * NCH * 4 * 2048 * 4 <= 8 * MiB + 512 * 1024 && WS_SST + (size_t)2 * NCH * 4 * 2048 * 2 <= WS_END, "ws map 2");
static_assert((size_t)CAP * D * 2 <= (size_t)MT * ZLD * 2 && (size_t)CAP * D * 2 + (size_t)CAP * FFE * 2 <= (size_t)MT * GLD * 2, "moe alias");
constexpr int CW_CNT = 0;
constexpr int CW_BAR = 8192;
constexpr int CW_WODONE = 65536;
constexpr int CW_WMAX = 12800;
constexpr int CW_WMAX13 = 12928;
constexpr int CW_MDONE = 53248;
constexpr int CW_E1DONE = 32768;
constexpr int CW_SCAN = 28672;
constexpr int CW_KMAXG = 24576;
constexpr int CW_KMAX = 16384;

__device__ __forceinline__ unsigned cvtpk(float lo, float hi) { f32x2 v = {lo, hi}; bf16x2_t b = __builtin_convertvector(v, bf16x2_t); return __builtin_bit_cast(unsigned, b); }
__device__ __forceinline__ unsigned pk4_fp8(float a, float b, float c, float d) { int w = 0; w = __builtin_amdgcn_cvt_pk_fp8_f32(a, b, w, false); w = __builtin_amdgcn_cvt_pk_fp8_f32(c, d, w, true); return (unsigned)w; }
__device__ __forceinline__ unsigned pk4_i8(float a, float b, float c, float d) {
    const int ia = (int)__builtin_rintf(a), ib = (int)__builtin_rintf(b), ic = (int)__builtin_rintf(c), id = (int)__builtin_rintf(d);
    return (unsigned)(ia & 255) | ((unsigned)(ib & 255) << 8) | ((unsigned)(ic & 255) << 16) | ((unsigned)id << 24); }
__device__ __forceinline__ float bflo(unsigned u) { return __uint_as_float(u << 16); }
__device__ __forceinline__ float bfhi(unsigned u) { return __uint_as_float(u & 0xffff0000u); }
__device__ __forceinline__ float bf2f(bf16_t h) { return __uint_as_float(((unsigned)h) << 16); }
__device__ __forceinline__ bf16_t f2bf(float f) { return (bf16_t)(cvtpk(f, 0.f) & 0xffffu); }
template <int CTRL> __device__ __forceinline__ float dpp_f(float v) { return __int_as_float(__builtin_amdgcn_update_dpp(0, __float_as_int(v), CTRL, 0xf, 0xf, true)); }
__device__ __forceinline__ float xor1_f(float v) { return dpp_f<0xB1>(v); }
__device__ __forceinline__ float swap32_other(float v, int lane) {
    auto rr = __builtin_amdgcn_permlane32_swap(__float_as_uint(v), __float_as_uint(v), false, false);
    return __uint_as_float(lane < 32 ? rr[1] : rr[0]);
}
__device__ __forceinline__ float wave_sum(float v) {
    v += dpp_f<0xB1>(v); v += dpp_f<0x4E>(v); v += dpp_f<0x141>(v); v += dpp_f<0x140>(v);
    { auto rr = __builtin_amdgcn_permlane16_swap(__float_as_uint(v), __float_as_uint(v), false, false); v = __uint_as_float(rr[0]) + __uint_as_float(rr[1]); }
    { auto rr = __builtin_amdgcn_permlane32_swap(__float_as_uint(v), __float_as_uint(v), false, false); v = __uint_as_float(rr[0]) + __uint_as_float(rr[1]); }
    return v;
}
__device__ __forceinline__ float wave_max(float v) {
    v = fmaxf(v, dpp_f<0xB1>(v)); v = fmaxf(v, dpp_f<0x4E>(v)); v = fmaxf(v, dpp_f<0x141>(v)); v = fmaxf(v, dpp_f<0x140>(v));
    { auto rr = __builtin_amdgcn_permlane16_swap(__float_as_uint(v), __float_as_uint(v), false, false); v = fmaxf(__uint_as_float(rr[0]), __uint_as_float(rr[1])); }
    { auto rr = __builtin_amdgcn_permlane32_swap(__float_as_uint(v), __float_as_uint(v), false, false); v = fmaxf(__uint_as_float(rr[0]), __uint_as_float(rr[1])); }
    return v;
}
__device__ __forceinline__ float wave_sum16(const float (&p)[16], int lane) {
    float q[8], r[4], u[2];
#pragma unroll
    for (int i = 0; i < 8; ++i) { auto rr = __builtin_amdgcn_permlane32_swap(__float_as_uint(p[i]), __float_as_uint(p[i + 8]), false, false); q[i] = __uint_as_float(rr[0]) + __uint_as_float(rr[1]); }
#pragma unroll
    for (int i = 0; i < 4; ++i) { auto rr = __builtin_amdgcn_permlane16_swap(__float_as_uint(q[i]), __float_as_uint(q[i + 4]), false, false); r[i] = __uint_as_float(rr[0]) + __uint_as_float(rr[1]); }
    const bool b3 = (lane & 8) != 0, b2 = (lane & 4) != 0;
#pragma unroll
    for (int i = 0; i < 2; ++i) { const float keep = b3 ? r[i + 2] : r[i], send = b3 ? r[i] : r[i + 2]; u[i] = keep + dpp_f<0x140>(send); }
    float v; { const float keep = b2 ? u[1] : u[0], send = b2 ? u[0] : u[1]; v = keep + dpp_f<0x141>(send); }
    v += dpp_f<0xB1>(v); v += dpp_f<0x4E>(v);
    return v;
}
__device__ __forceinline__ float sigmoidf_(float x) { return __builtin_amdgcn_rcpf(1.f + __expf(-x)); }
__device__ __forceinline__ float siluf_(float x) { return x * sigmoidf_(x); }
#define LDS_WAIT() asm volatile("s_waitcnt lgkmcnt(0)" ::: "memory")
template <class V> __device__ __forceinline__ void st8_wt(void* p, const V& v) { asm volatile("global_store_dwordx2 %0, %1, off sc1\n\ts_nop 1" :: "v"(p), "v"(v) : "memory"); }
template <class V> __device__ __forceinline__ void st16_wt(void* p, const V& v) { asm volatile("global_store_dwordx4 %0, %1, off sc1\n\ts_nop 1" :: "v"(p), "v"(v) : "memory"); }

__device__ __forceinline__ void tile_put(LAS unsigned char* st, int row, int col, float v) { *(LAS bf16_t*)(st + row * 128 + col * 2) = f2bf(v); }
__device__ __forceinline__ void tile_flush(const LAS unsigned char* st, bf16_t* dst, int ldd, int lane) {
    asm volatile("s_waitcnt lgkmcnt(0)" ::: "memory");
#pragma unroll
    for (int j = 0; j < 4; ++j) { const int row = (lane >> 3) + 8 * j, ch = lane & 7;
        const u32x4 v = *(const LAS u32x4*)(st + row * 128 + ch * 16);
        *(u32x4*)(dst + (size_t)row * ldd + ch * 8) = v; }
    asm volatile("s_waitcnt lgkmcnt(0)" ::: "memory");
}
namespace pg8 {
constexpr int BM = 256, BK = 64, HALF = 128, HTB = HALF * BK * 2, STAGE_BYTES = 8 * HTB, NXCD = 8, WGM = 8;
__device__ __forceinline__ int lds_byte(int r, int c) { return r * 128 + ((((c >> 3) ^ (r >> 1)) & 7) * 16) + (c & 7) * 2; }
__device__ __forceinline__ void stage_rc(int b, int& R, int& C) { R = b >> 7; C = ((((b >> 4) ^ (R >> 1)) & 7) * 8); }
__device__ __forceinline__ int perm32(int rho) { const int n = rho >> 4, i = rho & 15; return 8 * (i >> 2) + 4 * n + (i & 3); }

struct Unit { int pm, pn, aux; unsigned aoff, boff; };
struct Gemm { const bf16_t* A; const bf16_t* Bt; int lda, ldb, K; };

__device__ __forceinline__ bool dense_tile(long L, int nM, int nN, int& pm, int& pn) {
    const int nwg = nM * nN; if (L >= nwg) return false;
    int wgid = (int)L; { const int q = nwg / NXCD, r = nwg % NXCD, xcd = wgid % NXCD, off = wgid / NXCD; wgid = (xcd < r ? xcd * (q + 1) : r * (q + 1) + (xcd - r) * q) + off; }
    const int nig = WGM * nN, gid = wgid / nig, fm = gid * WGM, gsz = (nM - fm) < WGM ? (nM - fm) : WGM;
    pm = fm + ((wgid % nig) % gsz); pn = (wgid % nig) / gsz; return true;
}
struct DenseOrder {
    static constexpr bool GATHER = false;
    __device__ __forceinline__ void a_ready(const Unit&, int) const {}
    __device__ __forceinline__ void done(const Unit&, int) const {}
    int nM, nN, G, c, lda, ldb;
    __device__ __forceinline__ bool next(int i, Unit& u) const {
        if (!dense_tile((long)i * G + c, nM, nN, u.pm, u.pn)) return false;
        u.aux = 0; u.aoff = (unsigned)(u.pm * BM * lda * 2); u.boff = (unsigned)(u.pn * BM * ldb * 2); return true;
    }
};
struct DenseOrderH {
    static constexpr bool GATHER = false;
    __device__ __forceinline__ void a_ready(const Unit&, int) const {}
    __device__ __forceinline__ void done(const Unit&, int) const {}
    int nM, nN, G, c, lda, ldb;
    __device__ __forceinline__ bool next(int i, Unit& u) const {
        if (!dense_tile((long)i * G + c, nM, nN, u.pm, u.pn)) return false;
        u.aux = 0; u.aoff = (unsigned)(u.pm * BM * lda * 2); u.boff = (unsigned)(u.pn * HALF * ldb * 2); return true;
    }
};
struct WoOrder {
    static constexpr bool GATHER = false;
    int nM, G, c; unsigned* done_cnt; unsigned* wo_cnt;
    __device__ __forceinline__ bool next(int i, Unit& u) const {
        const int rw = (nM * 4) % G, cr = (c + rw) % G;
        if (!dense_tile((long)i * G + cr, nM, 4, u.pm, u.pn)) return false;
        u.aux = 0; u.aoff = (unsigned)(u.pm * BM * D * 2); u.boff = (unsigned)(u.pn * BM * D * 2); return true;
    }
    __device__ __forceinline__ void done(const Unit& u, int tid) const {
        asm volatile("s_waitcnt vmcnt(0)" ::: "memory");
        if ((tid & 63) == 0) __hip_atomic_fetch_add(wo_cnt + 64 * u.pm, 1u, __ATOMIC_RELAXED, __HIP_MEMORY_SCOPE_AGENT);
    }
    __device__ __forceinline__ void a_ready(const Unit& u, int tid) const {
        if (tid < 64) { unsigned sp = 0;
            while ((unsigned)__builtin_amdgcn_readfirstlane(__hip_atomic_load(done_cnt + 64 * u.pm, __ATOMIC_RELAXED, __HIP_MEMORY_SCOPE_AGENT)) < 64u) { __builtin_amdgcn_s_sleep(2); if (++sp > (1u << 22)) break; }
            __builtin_amdgcn_fence(__ATOMIC_ACQUIRE, "agent");
            asm volatile("s_waitcnt vmcnt(0)" ::: "memory"); }
        asm volatile("" ::: "memory"); __builtin_amdgcn_s_barrier(); asm volatile("" ::: "memory");
    }
};
struct MergeOrder {
    static constexpr bool GATHER = false;
    __device__ __forceinline__ void a_ready(const Unit&, int) const {}
    __device__ __forceinline__ void done(const Unit& u, int tid) const {
        if (u.aux == 3) { asm volatile("s_waitcnt vmcnt(0)" ::: "memory");
            if ((tid & 63) == 0) __hip_atomic_fetch_add(done_cnt + 64 * u.pm, 1u, __ATOMIC_RELAXED, __HIP_MEMORY_SCOPE_AGENT); }
    }
    unsigned* done_cnt;
    int nM, G, c;
    __device__ __forceinline__ bool next(int ui, Unit& u) const {
        const int rw = (nM * 4) % G, Gm = G - rw, ntile = nM * 8;
        if (c >= Gm) return false;
        long L = (long)(ui >> 2) * Gm + c; if (L >= ntile) return false;
        const int lastp = (nM % 8 == 1) ? 8 : 0;
        L = (L + ntile - lastp) % ntile;
        if (!dense_tile(L, nM, 8, u.pm, u.pn)) return false;
        const int i = ui & 3; u.aux = i;
        u.aoff = (unsigned)(u.pm * BM * D * 2 + i * 256 * 2); u.boff = (unsigned)((i * 1024 + u.pn * HALF) * 256 * 2); return true;
    }
};
template <bool GATHER_> struct MoeOrderT {
    static constexpr bool GATHER = GATHER_;
    const LAS int* tbl; int nunits, G, c, lda, ldb; const unsigned short* inv;
    unsigned* done_cnt;
    __device__ __forceinline__ bool next(int i, Unit& u) const {
        int L;
        if (GATHER) { L = i * G + c; if (L >= nunits) return false; }
        else {
            const int full = nunits / G, r = nunits - full * G, base_rounds = (full > 0) ? full - 1 : 0, light = G - r;
            if (i < base_rounds) L = i * G + c;
            else { if (c < r) return false; L = base_rounds * G + (c - r) + (i - base_rounds) * light; if (L >= nunits) return false; }
        }
        u.pm = L >> 2; const int pl = L & 3; const int e = __builtin_amdgcn_readfirstlane(tbl[u.pm]); u.pn = e * 4 + pl; u.aux = e;
        u.aoff = GATHER ? 0u : (unsigned)(u.pm * BM * lda * 2); u.boff = (unsigned)(u.pn * BM * ldb * 2); return true;
    }
    __device__ __forceinline__ unsigned arow(const Unit& u, int r) const {
        const int e = u.aux, st = __builtin_amdgcn_readfirstlane(tbl[160 + e]), cn = __builtin_amdgcn_readfirstlane(tbl[176 + e]);
        const int slot = u.pm * BM + r - st;
        const unsigned tok = (slot < cn) ? (unsigned)inv[(size_t)e * MT + slot] : 0u;
        return tok * (unsigned)(lda * 2);
    }
    __device__ __forceinline__ void done(const Unit& u, int tid) const {
        if (GATHER) { asm volatile("s_waitcnt vmcnt(0)" ::: "memory");
            if ((tid & 63) == 0) __hip_atomic_fetch_add(done_cnt + 64 * u.pm, 1u, __ATOMIC_RELAXED, __HIP_MEMORY_SCOPE_AGENT); }
    }
    __device__ __forceinline__ void a_ready(const Unit& u, int tid) const {
        if (!GATHER) {
            if (tid < 64) { unsigned sp = 0;
                while ((unsigned)__builtin_amdgcn_readfirstlane(__hip_atomic_load(done_cnt + 64 * u.pm, __ATOMIC_RELAXED, __HIP_MEMORY_SCOPE_AGENT)) < 32u) { __builtin_amdgcn_s_sleep(2); if (++sp > (1u << 22)) break; }
                __builtin_amdgcn_fence(__ATOMIC_ACQUIRE, "agent");
                asm volatile("s_waitcnt vmcnt(0)" ::: "memory"); }
            asm volatile("" ::: "memory"); __builtin_amdgcn_s_barrier(); asm volatile("" ::: "memory");
        }
    }
};
__device__ __forceinline__ int moe_table(LAS int* tbl, const unsigned* cnt, int tid) {
    int pst[NE], cn[NE]; int tot = 0;
#pragma unroll
    for (int e = 0; e < NE; ++e) { cn[e] = (int)__builtin_amdgcn_readfirstlane(__hip_atomic_load(cnt + e * 64, __ATOMIC_RELAXED, __HIP_MEMORY_SCOPE_AGENT)); pst[e] = tot; tot += (cn[e] + 255) / 256 * 256; }
    if (tid < 160) { int e = 0;
#pragma unroll
        for (int k = 1; k < NE; ++k) if (tid * 256 >= pst[k]) e = k;
        tbl[tid] = e; }
#pragma unroll
    for (int e = 0; e < NE; ++e) if (tid == 160 + e) { tbl[160 + e] = pst[e]; tbl[176 + e] = cn[e]; }
    __syncthreads();
    return tot / 256;
}

template <class Epi, class Sched>
__device__ __forceinline__ void gemm_phase(LAS unsigned char* lds, int tid, const Gemm g, const Sched& S, const Epi& E) {
    const int wid = __builtin_amdgcn_readfirstlane(tid >> 6), lane = tid & 63, wr = wid >> 2, wc = wid & 3, fr = lane & 15, fq = lane >> 4;
    const int K = g.K, nt = K / BK;
    unsigned cv0[2], cv1[2], nv0[2], nv1[2], voffB[2]; int RA[2], CA[2];
#pragma unroll
    for (int i = 0; i < 2; ++i) { int R, C; stage_rc(tid * 16 + i * 8192, R, C); const int Rb = Epi::PERM ? ((R & ~31) + perm32(R & 31)) : R; RA[i] = R; CA[i] = C;
        cv0[i] = (unsigned)(R * g.lda + C) * 2u; cv1[i] = cv0[i] + (unsigned)(HALF * g.lda * 2); nv0[i] = cv0[i]; nv1[i] = cv1[i]; voffB[i] = (unsigned)(Rb * g.ldb + C) * 2u; }
    const size_t kstep = (size_t)(BK * 2);
    const size_t hsB = Epi::HALFN ? (size_t)0 : (size_t)HALF * g.ldb * 2;
    const unsigned ldsw = (unsigned)wid * 1024u;
    const int aoff = lds_byte(wr * 64 + fr, fq * 8), boff = lds_byte(wc * 32 + fr, fq * 8), aoff1 = lds_byte(wr * 64 + fr, 32 + fq * 8), boff1 = lds_byte(wc * 32 + fr, 32 + fq * 8);
#define PG8_SA(b, h) (((b) * 2 + (h)) * HTB)
#define PG8_SB(b, h) ((4 + (b) * 2 + (h)) * HTB)
#define PG8_STAGE(bufoff, gbase, voff) do { _Pragma("unroll") for (int _i = 0; _i < 2; ++_i) \
        __builtin_amdgcn_global_load_lds((const unsigned*)((const char*)(gbase) + (voff)[_i]), (LAS unsigned*)(lds + (bufoff) + ldsw + _i * 8192), 16, 0, 0); } while (0)
#define PG8_LDA(dst, b, h) do { _Pragma("unroll") for (int m = 0; m < 4; ++m) { \
        if constexpr (Epi::F8) { const i32x4 lo_ = *(const LAS i32x4*)(lds + PG8_SA(b, h) + aoff + m * 2048), hi_ = *(const LAS i32x4*)(lds + PG8_SA(b, h) + aoff1 + m * 2048); dst##8[m] = __builtin_shufflevector(lo_, hi_, 0, 1, 2, 3, 4, 5, 6, 7); } \
        else { _Pragma("unroll") for (int k = 0; k < 2; ++k) dst[m][k] = *(const LAS bf16x8*)(lds + PG8_SA(b, h) + (k ? aoff1 : aoff) + m * 2048); } } } while (0)
#define PG8_LDB(dst, b, h) do { _Pragma("unroll") for (int n = 0; n < 2; ++n) { \
        if constexpr (Epi::F8) { const i32x4 lo_ = *(const LAS i32x4*)(lds + PG8_SB(b, h) + boff + n * 2048), hi_ = *(const LAS i32x4*)(lds + PG8_SB(b, h) + boff1 + n * 2048); dst##8[n] = __builtin_shufflevector(lo_, hi_, 0, 1, 2, 3, 4, 5, 6, 7); } \
        else { _Pragma("unroll") for (int k = 0; k < 2; ++k) dst[n][k] = *(const LAS bf16x8*)(lds + PG8_SB(b, h) + (k ? boff1 : boff) + n * 2048); } } } while (0)
#define PG8_MMA(ai, bj, At, Bt) do { __builtin_amdgcn_s_setprio(1); _Pragma("unroll") for (int m = 0; m < 4; ++m) _Pragma("unroll") for (int n = 0; n < 2; ++n) { \
        if constexpr (Epi::F8) acc[ai][bj][m][n] = __builtin_amdgcn_mfma_scale_f32_16x16x128_f8f6f4(Bt##8[n], At##8[m], acc[ai][bj][m][n], 0, 0, 0, 0, 0, 0); \
        else if constexpr (Epi::I8) { _Pragma("unroll") for (int k = 0; k < 2; ++k) acc[ai][bj][m][n] = __builtin_bit_cast(f32x4, __builtin_amdgcn_mfma_i32_16x16x64_i8(__builtin_bit_cast(i32x4, Bt[n][k]), __builtin_bit_cast(i32x4, At[m][k]), __builtin_bit_cast(i32x4, acc[ai][bj][m][n]), 0, 0, 0)); } \
        else { _Pragma("unroll") for (int k = 0; k < 2; ++k) acc[ai][bj][m][n] = __builtin_amdgcn_mfma_f32_16x16x32_bf16(Bt[n][k], At[m][k], acc[ai][bj][m][n], 0, 0, 0); } } \
        __builtin_amdgcn_s_setprio(0); } while (0)
#define PG8_WAIT_V(n) asm volatile("s_waitcnt vmcnt(" #n ")" ::: "memory")
#define PG8_WAIT_L(n) asm volatile("s_waitcnt lgkmcnt(" #n ")" ::: "memory")
#define PG8_BAR __builtin_amdgcn_s_barrier()
#define PG8_SCHED __builtin_amdgcn_sched_barrier(0)
    Unit cur, nxt; int ui = 0;
    if (!S.next(0, cur)) return;
    S.a_ready(cur, tid);
    f32x4 acc[2][2][4][2];
#pragma unroll
    for (int a = 0; a < 2; ++a)
#pragma unroll
        for (int b = 0; b < 2; ++b)
#pragma unroll
            for (int m = 0; m < 4; ++m)
#pragma unroll
                for (int n = 0; n < 2; ++n) acc[a][b][m][n] = (f32x4){0.f, 0.f, 0.f, 0.f};
    bf16x8 At[4][2], B0[2][2], B1[2][2];
    i32x8 At8[4], B08[2], B18[2];
    const char* cA = (const char*)g.A + cur.aoff; const char* cB = (const char*)g.Bt + cur.boff;
    if constexpr (Sched::GATHER) {
#pragma unroll
        for (int i = 0; i < 2; ++i) { cv0[i] = S.arow(cur, RA[i]) + (unsigned)(CA[i] * 2); cv1[i] = S.arow(cur, HALF + RA[i]) + (unsigned)(CA[i] * 2); nv0[i] = cv0[i]; nv1[i] = cv1[i]; }
    }
    PG8_STAGE(PG8_SB(0, 0), cB, voffB); PG8_STAGE(PG8_SB(0, 1), cB + hsB, voffB); PG8_STAGE(PG8_SA(0, 0), cA, cv0); PG8_STAGE(PG8_SA(0, 1), cA, cv1);
    if (wr == 1) PG8_BAR;
    PG8_WAIT_V(2); PG8_BAR;
    PG8_STAGE(PG8_SB(1, 0), cB + kstep, voffB); PG8_STAGE(PG8_SA(1, 0), cA + kstep, cv0); PG8_STAGE(PG8_SB(1, 1), cB + hsB + kstep, voffB);
    PG8_WAIT_V(6); PG8_BAR;
    for (;;) {
        const bool has_next = S.next(ui + 1, nxt);
        const char* nA = has_next ? (const char*)g.A + nxt.aoff : cA; const char* nB = has_next ? (const char*)g.Bt + nxt.boff : cB;
        if constexpr (Sched::GATHER) {
#pragma unroll
            for (int i = 0; i < 2; ++i) { nv0[i] = has_next ? S.arow(nxt, RA[i]) + (unsigned)(CA[i] * 2) : cv0[i]; nv1[i] = has_next ? S.arow(nxt, HALF + RA[i]) + (unsigned)(CA[i] * 2) : cv1[i]; }
        }
#pragma unroll 1
        for (int t = 0; t < nt; t += 2) {
            const bool last = (t == nt - 2);
            const char* a1 = cA + (size_t)(t + 1) * kstep;
            const char* a2 = last ? nA : cA + (size_t)(t + 2) * kstep; const char* b2 = last ? nB : cB + (size_t)(t + 2) * kstep;
            const char* a3 = a2 + kstep; const char* b3 = b2 + kstep;
            if (last && has_next) S.a_ready(nxt, tid);
            unsigned s0[2], s1[2];
#pragma unroll
            for (int i = 0; i < 2; ++i) { s0[i] = (Sched::GATHER && last) ? nv0[i] : cv0[i]; s1[i] = (Sched::GATHER && last) ? nv1[i] : cv1[i]; }
            PG8_LDB(B0, 0, 0); if constexpr (!Epi::HALFN) PG8_LDB(B1, 0, 1); PG8_SCHED; PG8_LDA(At, 0, 0); PG8_STAGE(PG8_SA(1, 1), a1, cv1);
            PG8_WAIT_V(8); PG8_WAIT_L(0); PG8_BAR; PG8_MMA(0, 0, At, B0); if constexpr (!Epi::HALFN) PG8_MMA(0, 1, At, B1); PG8_BAR; PG8_SCHED;
            PG8_LDA(At, 0, 1); PG8_STAGE(PG8_SB(0, 0), b2, voffB); PG8_STAGE(PG8_SB(0, 1), b2 + hsB, voffB); PG8_STAGE(PG8_SA(0, 0), a2, s0);
            PG8_WAIT_V(8); PG8_WAIT_L(0); PG8_BAR; PG8_MMA(1, 0, At, B0); if constexpr (!Epi::HALFN) PG8_MMA(1, 1, At, B1); PG8_BAR; PG8_SCHED;
            PG8_LDB(B0, 1, 0); if constexpr (!Epi::HALFN) PG8_LDB(B1, 1, 1); PG8_SCHED; PG8_LDA(At, 1, 0); PG8_STAGE(PG8_SA(0, 1), a2, s1);
            PG8_WAIT_V(8); PG8_WAIT_L(0); PG8_BAR; PG8_MMA(0, 0, At, B0); if constexpr (!Epi::HALFN) PG8_MMA(0, 1, At, B1); PG8_BAR; PG8_SCHED;
            PG8_LDA(At, 1, 1); PG8_STAGE(PG8_SB(1, 0), b3, voffB); PG8_STAGE(PG8_SB(1, 1), b3 + hsB, voffB); PG8_STAGE(PG8_SA(1, 0), a3, s0);
            PG8_WAIT_V(8); PG8_WAIT_L(0); PG8_BAR; PG8_MMA(1, 0, At, B0); if constexpr (!Epi::HALFN) PG8_MMA(1, 1, At, B1); PG8_BAR; PG8_SCHED;
        }
        if (wr == 0) PG8_BAR;
        { int l2_; asm volatile("v_mbcnt_lo_u32_b32 %0, -1, 0\n\tv_mbcnt_hi_u32_b32 %0, -1, %0" : "=v"(l2_)); E(acc, cur, wr, wc, l2_ & 15, l2_ >> 4); }
        S.done(cur, tid);
        if (!has_next) break;
        if constexpr (!Epi::HALFN)
#pragma unroll
        for (int a = 0; a < 2; ++a)
#pragma unroll
            for (int b = 0; b < 2; ++b)
#pragma unroll
                for (int m = 0; m < 4; ++m)
#pragma unroll
                    for (int n = 0; n < 2; ++n) acc[a][b][m][n] = (f32x4){0.f, 0.f, 0.f, 0.f};
        cur = nxt; cA = nA; cB = nB; ++ui;
        if constexpr (Sched::GATHER) {
#pragma unroll
            for (int i = 0; i < 2; ++i) { cv0[i] = nv0[i]; cv1[i] = nv1[i]; }
        }
        if (wr == 1) PG8_BAR;
    }
    PG8_WAIT_V(0);
    PG8_BAR;
#undef PG8_SA
#undef PG8_SB
#undef PG8_STAGE
#undef PG8_LDA
#undef PG8_LDB
#undef PG8_MMA
#undef PG8_WAIT_V
#undef PG8_WAIT_L
#undef PG8_BAR
#undef PG8_SCHED
}

struct EpiIn {
    static constexpr bool F8 = false, I8 = false;
    static constexpr bool HALFN = false;
    static constexpr bool PERM = true;
    bf16_t* Z; bf16_t* Gt; const float* bgate; const float* rope;
    __device__ __forceinline__ void operator()(f32x4 (&acc)[2][2][4][2], const Unit& u, int wr, int wc, int fr, int fq) const {
        const int row0 = u.pm * BM + wr * 64 + fr;
        if (u.pn < 11) {
            const bool dorope = (u.pn == 5 || u.pn == 6 || u.pn == 8) && (u.pm < SEQ / BM);
            const int col0 = u.pn * BM + wc * 32 + 8 * fq;
#pragma unroll
            for (int ai = 0; ai < 2; ++ai)
#pragma unroll
                for (int m = 0; m < 4; ++m) {
                    const int row = row0 + ai * HALF + m * 16;
                    f32x4 cs0, cs1, sn0, sn1;
                    if (dorope) { const int pos = (fq & 1) ? (row & 63) : (row >> 6); const f32x4* rp = (const f32x4*)(rope + pos * 16); cs0 = rp[0]; cs1 = rp[1]; sn0 = rp[2]; sn1 = rp[3]; }
#pragma unroll
                    for (int bj = 0; bj < 2; ++bj) {
                        f32x4 v0 = acc[ai][bj][m][0], v1 = acc[ai][bj][m][1];
                        if (dorope) {
                            f32x4 o0, o1;
#pragma unroll
                            for (int e = 0; e < 4; ++e) { o0[e] = swap32_other(v0[e], fq * 16); o1[e] = swap32_other(v1[e], fq * 16); }
                            if (fq < 2) { v0 = v0 * cs0 - o0 * sn0; v1 = v1 * cs1 - o1 * sn1; }
                            else        { v0 = o0 * sn0 + v0 * cs0; v1 = o1 * sn1 + v1 * cs1; }
                        }
                        float sc = 1.f; if (u.pn == 5) sc = QSCALE; if (u.pn == 8 && bj == 1) sc = RKSCALE;
                        v0 = v0 * sc; v1 = v1 * sc;
                        u32x4 w; w.x = cvtpk(v0[0], v0[1]); w.y = cvtpk(v0[2], v0[3]); w.z = cvtpk(v1[0], v1[1]); w.w = cvtpk(v1[2], v1[3]);
                        *(u32x4*)(Z + (size_t)row * ZLD + col0 + bj * HALF) = w;
                    }
                    asm volatile("" ::: "memory");
                }
        } else {
            const int col0 = (u.pn - 11) * BM + wc * 32 + 8 * fq;
            f32x4 bv[2][2];
#pragma unroll
            for (int bj = 0; bj < 2; ++bj)
#pragma unroll
                for (int n = 0; n < 2; ++n) bv[bj][n] = *(const f32x4*)(bgate + col0 + bj * HALF + 4 * n) * -1.4426950408889634f;
#pragma unroll
            for (int ai = 0; ai < 2; ++ai)
#pragma unroll
                for (int m = 0; m < 4; ++m) {
                    const int row = row0 + ai * HALF + m * 16;
#pragma unroll
                    for (int bj = 0; bj < 2; ++bj) {
                        f32x4 v0, v1;
#pragma unroll
                        for (int e = 0; e < 4; ++e) { v0[e] = __builtin_amdgcn_rcpf(1.f + __builtin_amdgcn_exp2f(__builtin_fmaf(acc[ai][bj][m][0][e], -1.4426950408889634f, bv[bj][0][e])));
                                                      v1[e] = __builtin_amdgcn_rcpf(1.f + __builtin_amdgcn_exp2f(__builtin_fmaf(acc[ai][bj][m][1][e], -1.4426950408889634f, bv[bj][1][e]))); }
                        u32x4 w; w.x = cvtpk(v0[0], v0[1]); w.y = cvtpk(v0[2], v0[3]); w.z = cvtpk(v1[0], v1[1]); w.w = cvtpk(v1[2], v1[3]);
                        *(u32x4*)(Gt + (size_t)row * GLD + col0 + bj * HALF) = w;
                    }
                    asm volatile("" ::: "memory");
                }
        }
    }
};
struct EpiInI8 {
    static constexpr bool F8 = false, I8 = true, HALFN = false, PERM = true;
    EpiIn base; const float* hs; const unsigned* wmax;
    __device__ __forceinline__ void operator()(f32x4 (&acc)[2][2][4][2], const Unit& u, int wr, int wc, int fr, int fq) const {
        const float sw = __uint_as_float(__hip_atomic_load(wmax, __ATOMIC_RELAXED, __HIP_MEMORY_SCOPE_AGENT)) * (1.f / 127.f);
        const int row0 = u.pm * BM + wr * 64 + fr;
#pragma unroll
        for (int ai = 0; ai < 2; ++ai)
#pragma unroll
            for (int m = 0; m < 4; ++m) { const float sr = hs[row0 + ai * HALF + m * 16] * sw;
#pragma unroll
                for (int bj = 0; bj < 2; ++bj)
#pragma unroll
                    for (int n = 0; n < 2; ++n)
#pragma unroll
                        for (int e = 0; e < 4; ++e) acc[ai][bj][m][n][e] = (float)__float_as_int(acc[ai][bj][m][n][e]) * sr; }
        base(acc, u, wr, wc, fr, fq);
    }
};
struct EpiGate8 {
    static constexpr bool F8 = true, I8 = false, HALFN = true, PERM = true;
    bf16_t* Gt; const float* bgate;
    __device__ __forceinline__ void operator()(f32x4 (&acc)[2][2][4][2], const Unit& u, int wr, int wc, int fr, int fq) const {
        const int row0 = u.pm * BM + wr * 64 + fr, col0 = u.pn * HALF + wc * 32 + 8 * fq;
        f32x4 bv[2];
#pragma unroll
        for (int n = 0; n < 2; ++n) bv[n] = *(const f32x4*)(bgate + col0 + 4 * n) * -1.4426950408889634f;
#pragma unroll
        for (int ai = 0; ai < 2; ++ai)
#pragma unroll
            for (int m = 0; m < 4; ++m) {
                const int row = row0 + ai * HALF + m * 16;
                f32x4 v0, v1;
#pragma unroll
                for (int e = 0; e < 4; ++e) { v0[e] = __builtin_amdgcn_rcpf(1.f + __builtin_amdgcn_exp2f(__builtin_fmaf(acc[ai][0][m][0][e], -1.4426950408889634f / 32.f, bv[0][e])));
                                              v1[e] = __builtin_amdgcn_rcpf(1.f + __builtin_amdgcn_exp2f(__builtin_fmaf(acc[ai][0][m][1][e], -1.4426950408889634f / 32.f, bv[1][e]))); }
                u32x4 w; w.x = cvtpk(v0[0], v0[1]); w.y = cvtpk(v0[2], v0[3]); w.z = cvtpk(v1[0], v1[1]); w.w = cvtpk(v1[2], v1[3]);
                *(u32x4*)(Gt + (size_t)row * GLD + col0) = w;
                acc[ai][0][m][0] = (f32x4){0.f, 0.f, 0.f, 0.f}; acc[ai][0][m][1] = (f32x4){0.f, 0.f, 0.f, 0.f};
                asm volatile("" ::: "memory");
            }
    }
};
struct EpiMerge {
    static constexpr bool PERM = true, HALFN = true, F8 = false, I8 = false;
    const bf16_t* Gt; bf16_t* Mb;
    __device__ __forceinline__ void operator()(f32x4 (&acc)[2][2][4][2], const Unit& u, int wr, int wc, int fr, int fq) const {
        const int row0 = u.pm * BM + wr * 64 + fr, col0 = u.pn * HALF + wc * 32 + 8 * fq, i = u.aux;
        u32x4 gw[2][4];
#pragma unroll
        for (int ai = 0; ai < 2; ++ai)
#pragma unroll
            for (int m = 0; m < 4; ++m) gw[ai][m] = *(const u32x4*)(Gt + (size_t)(row0 + ai * HALF + m * 16) * GLD + i * 1024 + col0);
#pragma unroll
        for (int ai = 0; ai < 2; ++ai)
#pragma unroll
            for (int m = 0; m < 4; ++m) {
                const u32x4 g = gw[ai][m];
                const f32x4 v0 = acc[ai][0][m][0], v1 = acc[ai][0][m][1];
                f32x4& s0 = acc[ai][1][m][0]; f32x4& s1 = acc[ai][1][m][1];
                s0[0] += v0[0] * bflo(g.x); s0[1] += v0[1] * bfhi(g.x); s0[2] += v0[2] * bflo(g.y); s0[3] += v0[3] * bfhi(g.y);
                s1[0] += v1[0] * bflo(g.z); s1[1] += v1[1] * bfhi(g.z); s1[2] += v1[2] * bflo(g.w); s1[3] += v1[3] * bfhi(g.w);
                acc[ai][0][m][0] = (f32x4){0.f, 0.f, 0.f, 0.f}; acc[ai][0][m][1] = (f32x4){0.f, 0.f, 0.f, 0.f};
            }
        if (i == 3) {
#pragma unroll
            for (int ai = 0; ai < 2; ++ai)
#pragma unroll
                for (int m = 0; m < 4; ++m) {
                    f32x4& s0 = acc[ai][1][m][0]; f32x4& s1 = acc[ai][1][m][1];
                    u32x4 w; w.x = cvtpk(s0[0], s0[1]); w.y = cvtpk(s0[2], s0[3]); w.z = cvtpk(s1[0], s1[1]); w.w = cvtpk(s1[2], s1[3]);
                    st16_wt(Mb + (size_t)(row0 + ai * HALF + m * 16) * D + col0, w);
                    s0 = (f32x4){0.f, 0.f, 0.f, 0.f}; s1 = (f32x4){0.f, 0.f, 0.f, 0.f};
                }
        }
    }
};
struct EpiWo {
    static constexpr bool F8 = false, I8 = false;
    static constexpr bool HALFN = false;
    static constexpr bool PERM = false;
    const float* base_l; float* out_l; const float* base_c; float* out_c; const float* gate_l; const float* gate_c;
    __device__ __forceinline__ void operator()(f32x4 (&acc)[2][2][4][2], const Unit& u, int wr, int wc, int fr, int fq) const {
        const bool isc = (u.pm == SEQ / BM);
        const float* base = isc ? base_c : base_l; float* out = isc ? out_c : out_l; const float* gate = isc ? gate_c : gate_l;
        const int row0 = (isc ? 0 : u.pm * BM) + wr * 64 + fr, col0 = u.pn * BM + wc * 32 + 4 * fq;
        f32x4 gv[2][2];
#pragma unroll
        for (int bj = 0; bj < 2; ++bj)
#pragma unroll
            for (int n = 0; n < 2; ++n) gv[bj][n] = *(const f32x4*)(gate + col0 + bj * HALF + n * 16);
#pragma unroll
        for (int ai = 0; ai < 2; ++ai) {
            f32x4 b[4][2][2];
#pragma unroll
            for (int m = 0; m < 4; ++m) { const size_t off = (size_t)(row0 + ai * HALF + m * 16) * D + col0;
#pragma unroll
                for (int bj = 0; bj < 2; ++bj)
#pragma unroll
                    for (int n = 0; n < 2; ++n) b[m][bj][n] = *(const f32x4*)(base + off + bj * HALF + n * 16); }
#pragma unroll
            for (int m = 0; m < 4; ++m) { const size_t off = (size_t)(row0 + ai * HALF + m * 16) * D + col0;
#pragma unroll
                for (int bj = 0; bj < 2; ++bj)
#pragma unroll
                    for (int n = 0; n < 2; ++n) { const f32x4 xo = b[m][bj][n] + gv[bj][n] * acc[ai][bj][m][n]; st16_wt(out + off + bj * HALF + n * 16, xo); } }
            asm volatile("" ::: "memory");
        }
    }
};
struct EpiE1 {
    static constexpr bool F8 = false, I8 = false;
    static constexpr bool HALFN = false;
    static constexpr bool PERM = true;
    bf16_t* U;
    __device__ __forceinline__ void operator()(f32x4 (&acc)[2][2][4][2], const Unit& u, int wr, int wc, int fr, int fq) const {
        const int row0 = u.pm * BM + wr * 64 + fr, col0 = (u.pn & 3) * 128 + wc * 32 + 8 * fq;
#pragma unroll
        for (int ai = 0; ai < 2; ++ai)
#pragma unroll
            for (int m = 0; m < 4; ++m) {
                const int row = row0 + ai * HALF + m * 16;
                f32x4 v0, v1;
#pragma unroll
                for (int e = 0; e < 4; ++e) { v0[e] = siluf_(acc[ai][0][m][0][e]) * acc[ai][1][m][0][e]; v1[e] = siluf_(acc[ai][0][m][1][e]) * acc[ai][1][m][1][e]; }
                u32x2 w; w.x = pk4_fp8(v0[0] * 2.f, v0[1] * 2.f, v0[2] * 2.f, v0[3] * 2.f); w.y = pk4_fp8(v1[0] * 2.f, v1[1] * 2.f, v1[2] * 2.f, v1[3] * 2.f);
                st8_wt((unsigned char*)U + (size_t)row * FFE + col0, w);
                asm volatile("" ::: "memory");
            }
    }
};
struct EpiE1I8 {
    static constexpr bool F8 = false, I8 = true, HALFN = false, PERM = true;
    EpiE1 base; const float* hss; const unsigned* wmax; const LAS int* tbl;
    __device__ __forceinline__ void operator()(f32x4 (&acc)[2][2][4][2], const Unit& u, int wr, int wc, int fr, int fq) const {
        const float sw = __uint_as_float(__hip_atomic_load(wmax, __ATOMIC_RELAXED, __HIP_MEMORY_SCOPE_AGENT)) * (1.f / 127.f);
        const int e = u.aux, st = __builtin_amdgcn_readfirstlane(tbl[160 + e]), cn = __builtin_amdgcn_readfirstlane(tbl[176 + e]);
        const int slot0 = u.pm * BM + wr * 64 + fr - st;
#pragma unroll
        for (int ai = 0; ai < 2; ++ai)
#pragma unroll
            for (int m = 0; m < 4; ++m) { const int slot = slot0 + ai * HALF + m * 16; const float sr = (slot < cn) ? hss[(size_t)e * MT + slot] * sw : 0.f;
#pragma unroll
                for (int bj = 0; bj < 2; ++bj)
#pragma unroll
                    for (int n = 0; n < 2; ++n)
#pragma unroll
                        for (int e4 = 0; e4 < 4; ++e4) acc[ai][bj][m][n][e4] = (float)__float_as_int(acc[ai][bj][m][n][e4]) * sr; }
        base(acc, u, wr, wc, fr, fq);
    }
};
struct EpiE2 {
    static constexpr bool F8 = false, I8 = false;
    static constexpr bool HALFN = false;
    static constexpr bool PERM = true;
    bf16_t* Ys;
    __device__ __forceinline__ void operator()(f32x4 (&acc)[2][2][4][2], const Unit& u, int wr, int wc, int fr, int fq) const {
        const int row0 = u.pm * BM + wr * 64 + fr, col0 = (u.pn & 3) * BM + wc * 32 + 8 * fq;
#pragma unroll
        for (int ai = 0; ai < 2; ++ai)
#pragma unroll
            for (int m = 0; m < 4; ++m) {
                const int row = row0 + ai * HALF + m * 16;
#pragma unroll
                for (int bj = 0; bj < 2; ++bj) { const f32x4 v0 = acc[ai][bj][m][0], v1 = acc[ai][bj][m][1];
                    u32x4 w; w.x = cvtpk(v0[0], v0[1]); w.y = cvtpk(v0[2], v0[3]); w.z = cvtpk(v1[0], v1[1]); w.w = cvtpk(v1[2], v1[3]);
                    *(u32x4*)(Ys + (size_t)row * D + col0 + bj * HALF) = w; }
                asm volatile("" ::: "memory");
            }
    }
};
struct EpiE2H8 {
    static constexpr bool F8 = true, I8 = false, HALFN = true, PERM = true;
    bf16_t* Ys;
    __device__ __forceinline__ void operator()(f32x4 (&acc)[2][2][4][2], const Unit& u, int wr, int wc, int fr, int fq) const {
        const int row0 = u.pm * BM + wr * 64 + fr, col0 = (u.pn & 7) * HALF + wc * 32 + 8 * fq;
#pragma unroll
        for (int ai = 0; ai < 2; ++ai)
#pragma unroll
            for (int m = 0; m < 4; ++m) {
                const int row = row0 + ai * HALF + m * 16;
                const f32x4 v0 = acc[ai][0][m][0] * (1.f / 64.f), v1 = acc[ai][0][m][1] * (1.f / 64.f);
                u32x4 w; w.x = cvtpk(v0[0], v0[1]); w.y = cvtpk(v0[2], v0[3]); w.z = cvtpk(v1[0], v1[1]); w.w = cvtpk(v1[2], v1[3]);
                *(u32x4*)(Ys + (size_t)row * D + col0) = w;
                acc[ai][0][m][0] = (f32x4){0.f, 0.f, 0.f, 0.f}; acc[ai][0][m][1] = (f32x4){0.f, 0.f, 0.f, 0.f};
                asm volatile("" ::: "memory");
            }
    }
};
struct MoeOrderE2H {
    static constexpr bool GATHER = false;
    const LAS int* tbl; int nblk, G, c, lda, ldb; unsigned* done_cnt;
    __device__ __forceinline__ bool next(int i, Unit& u) const {
        const int n1 = nblk * 4, n2 = nblk * 8, r1 = n1 - (n1 / G) * G, full2 = n2 / G, base_rounds = (full2 > 2) ? full2 - 2 : 0, light = G - r1;
        int L;
        if (i < base_rounds) L = i * G + c;
        else { if (c < r1) return false; L = base_rounds * G + (c - r1) + (i - base_rounds) * light; }
        if (L >= n2) return false;
        u.pm = L >> 3; const int e = __builtin_amdgcn_readfirstlane(tbl[u.pm]); u.pn = e * 8 + (L & 7); u.aux = e;
        u.aoff = (unsigned)(u.pm * BM * lda * 2); u.boff = (unsigned)(u.pn * HALF * ldb * 2); return true;
    }
    __device__ __forceinline__ void done(const Unit&, int) const {}
    __device__ __forceinline__ void a_ready(const Unit& u, int tid) const {
        if (tid < 64) { unsigned sp = 0;
            while ((unsigned)__builtin_amdgcn_readfirstlane(__hip_atomic_load(done_cnt + 64 * u.pm, __ATOMIC_RELAXED, __HIP_MEMORY_SCOPE_AGENT)) < 32u) { __builtin_amdgcn_s_sleep(2); if (++sp > (1u << 22)) break; }
            __builtin_amdgcn_fence(__ATOMIC_ACQUIRE, "agent");
            asm volatile("s_waitcnt vmcnt(0)" ::: "memory"); }
        asm volatile("" ::: "memory"); __builtin_amdgcn_s_barrier(); asm volatile("" ::: "memory");
    }
};
}

#define XB_TMO      128
#define XB_XCNT(j)  (256  + 64 * (j))
#define XB_XSUB(j)  (1280 + 64 * (j))
#define XB_XGEN(j)  (2304 + 64 * (j))
#define XB_TOP      3328
#define XB_TOPGEN   3392
#define XCD_BAR_WORDS 3456
#define XB_SPIN_CAP (1u << 20)
__device__ __forceinline__ unsigned xb_ld(unsigned* p)              { return __hip_atomic_load(p, __ATOMIC_RELAXED, __HIP_MEMORY_SCOPE_AGENT); }
__device__ __forceinline__ unsigned xb_add(unsigned* p, unsigned v) { return __hip_atomic_fetch_add(p, v, __ATOMIC_RELAXED, __HIP_MEMORY_SCOPE_AGENT); }
__device__ __forceinline__ unsigned xb_xcc_id() { return (unsigned)__builtin_amdgcn_s_getreg((3 << 11) | 20) & 0xFu; }
#define XB_SPIN(cond, bar) do { unsigned _sp = 0; while (cond) { __builtin_amdgcn_s_sleep(1); \
    if ((++_sp & 255u) == 0u) { if (xb_ld(&(bar)[XB_TMO])) break; if (_sp > XB_SPIN_CAP) { atomicAdd(&(bar)[XB_TMO], 1u); break; } } } } while (0)
__device__ __forceinline__ void xcd_barrier_complete(unsigned* bar, unsigned x, unsigned G, unsigned& nloc, unsigned& nx) {
    unsigned sum, cnt, mine, sp = 0u;
    for (;;) {
        sum = 0u; cnt = 0u; mine = 0u;
#pragma unroll
        for (unsigned j = 0; j < 16; ++j) { const unsigned c = xb_ld(&bar[XB_XCNT(j)]); sum += c; cnt += (c > 0u) ? 1u : 0u; mine = (j == x) ? c : mine; }
        if (sum == G) break;
        __builtin_amdgcn_s_sleep(1);
        if ((++sp & 255u) == 0u) { if (xb_ld(&bar[XB_TMO])) break; if (sp > XB_SPIN_CAP) { atomicAdd(&bar[XB_TMO], 1u); break; } }
    }
    nloc = mine > 0u ? mine : 1u; nx = cnt > 0u ? cnt : 1u;
}
__device__ __forceinline__ void xcd_barrier(unsigned* bar, volatile LAS unsigned* st, int tid, unsigned G) {
    asm volatile("s_waitcnt vmcnt(0)" ::: "memory");
    __syncthreads();
    if (tid == 0) {
        const unsigned x = xb_xcc_id();
        __builtin_amdgcn_s_waitcnt(0);
        unsigned nloc = st[0], nx = st[1];
        if (nloc == 0u) { xcd_barrier_complete(bar, x, G, nloc, nx); st[0] = nloc; st[1] = nx; }
        const unsigned old = xb_add(&bar[XB_XSUB(x)], 1u);
        const unsigned gen = old / nloc;
        if (old + 1u == (gen + 1u) * nloc) {
            __builtin_amdgcn_fence(__ATOMIC_RELEASE, "agent");
            asm volatile("s_waitcnt vmcnt(0)" ::: "memory");
            const unsigned og = xb_add(&bar[XB_TOP], 1u);
            const unsigned tg = og / nx;
            if (og + 1u == (tg + 1u) * nx) xb_add(&bar[XB_TOPGEN], 1u);
            else XB_SPIN(xb_ld(&bar[XB_TOPGEN]) == tg, bar);
            __builtin_amdgcn_fence(__ATOMIC_ACQUIRE, "agent");
            xb_add(&bar[XB_XGEN(x)], 1u);
            asm volatile("s_waitcnt vmcnt(0)" ::: "memory");
        } else {
            XB_SPIN(xb_ld(&bar[XB_XGEN(x)]) == gen, bar);
            __builtin_amdgcn_fence(__ATOMIC_ACQUIRE, "agent");
            asm volatile("s_waitcnt vmcnt(0)" ::: "memory");
        }
    }
    __syncthreads();
}

struct Args { const float* in[31]; float* out; unsigned char* ws; int ph_lo, ph_hi; };
struct Frame {
    LAS unsigned char* lds;
    int tid, lane, wave, G, bid, gw, NGW;
    const float* const* in; float* out; unsigned char* ws;
};
#define WSP(T, off) ((T*)(F.ws + (off)))

__device__ __forceinline__ void transpose_item_fp8(const float* W, int K, int N, unsigned char* WT, float sc, LAS float* scr, int item, int lane) {
    const int nblk = N / 64, kb = item / nblk, nb = item % nblk, k0 = 64 * kb, n0 = 64 * nb;
    const int q = lane & 15, r = lane >> 4;
    f32x4 v[16];
#pragma unroll
    for (int i = 0; i < 16; ++i) v[i] = __builtin_nontemporal_load((const f32x4*)(W + (size_t)(k0 + 4 * i + r) * N + n0 + 4 * q));
#pragma unroll
    for (int i = 0; i < 16; ++i) { LAS float* d = scr + (4 * i + r) * 65 + 4 * q; d[0] = v[i][0]; d[1] = v[i][1]; d[2] = v[i][2]; d[3] = v[i][3]; }
    LDS_WAIT(); asm volatile("" ::: "memory");
    const int c = lane & 7;
#pragma unroll
    for (int j = 0; j < 8; ++j) { const int n = (lane >> 3) + 8 * j; const LAS float* s_ = scr + (8 * c) * 65 + n;
        u32x2 o; o.x = pk4_fp8(s_[0 * 65] * sc, s_[1 * 65] * sc, s_[2 * 65] * sc, s_[3 * 65] * sc); o.y = pk4_fp8(s_[4 * 65] * sc, s_[5 * 65] * sc, s_[6 * 65] * sc, s_[7 * 65] * sc);
        *(u32x2*)(WT + (size_t)(n0 + n) * K + k0 + 8 * c) = o; }
    LDS_WAIT(); asm volatile("" ::: "memory");
}
__device__ __forceinline__ void transpose_item_i8(const float* W, int K, int N, unsigned char* WT, float sc, LAS float* scr, int item, int lane, int imode = 0) {
    const int nblk = N / 64, kb = item / nblk, nb = item % nblk, k0 = 64 * kb, n0 = 64 * nb;
    const int q = lane & 15, r = lane >> 4;
    f32x4 v[16];
#pragma unroll
    for (int i = 0; i < 16; ++i) v[i] = __builtin_nontemporal_load((const f32x4*)(W + (size_t)(k0 + 4 * i + r) * N + n0 + 4 * q));
#pragma unroll
    for (int i = 0; i < 16; ++i) { LAS float* d = scr + (4 * i + r) * 65 + 4 * q; d[0] = v[i][0]; d[1] = v[i][1]; d[2] = v[i][2]; d[3] = v[i][3]; }
    LDS_WAIT(); asm volatile("" ::: "memory");
    const int c = lane & 7;
#pragma unroll
    for (int j = 0; j < 8; ++j) { const int n = (lane >> 3) + 8 * j; const LAS float* s_ = scr + (8 * c) * 65 + n;
        u32x2 o; o.x = pk4_i8(s_[0 * 65] * sc, s_[1 * 65] * sc, s_[2 * 65] * sc, s_[3 * 65] * sc); o.y = pk4_i8(s_[4 * 65] * sc, s_[5 * 65] * sc, s_[6 * 65] * sc, s_[7 * 65] * sc);
        const int ng = n0 + n; const int drow = (imode == 0) ? ng : ((ng >> 7) * 256 + (ng & 127) + (imode == 2 ? 128 : 0));
        *(u32x2*)(WT + (size_t)drow * K + k0 + 8 * c) = o; }
    LDS_WAIT(); asm volatile("" ::: "memory");
}
__device__ __forceinline__ void w13absmax_items(Frame& F, int l) {
    float am = 0.f;
    const f32x4* a = (const f32x4*)(F.in[27] + (size_t)l * NE * D * FFE); const f32x4* b = (const f32x4*)(F.in[28] + (size_t)l * NE * D * FFE);
    const int n4 = NE * D * FFE / 4;
#pragma unroll 4
    for (int i = F.bid * NTHR + F.tid; i < n4; i += F.G * NTHR) { const f32x4 v = __builtin_nontemporal_load(a + i), w = __builtin_nontemporal_load(b + i);
        am = fmaxf(am, fmaxf(fmaxf(fmaxf(fabsf(v[0]), fabsf(v[1])), fmaxf(fabsf(v[2]), fabsf(v[3]))), fmaxf(fmaxf(fabsf(w[0]), fabsf(w[1])), fmaxf(fabsf(w[2]), fabsf(w[3]))))); }
    am = wave_max(am);
    if (F.lane == 0) atomicMax(WSP(unsigned, WS_CTL) + CW_WMAX13 + l * 64, __float_as_uint(am));
}
__device__ __forceinline__ void wabsmax_items(Frame& F, int l0, int l1) {
    for (int l = l0; l < l1; ++l) {
        float am = 0.f;
        const f32x4* a = (const f32x4*)(F.in[8] + (size_t)l * D * ZLD); const f32x4* b = (const f32x4*)(F.in[21] + (size_t)l * D * GLD);
        for (int i = F.bid * NTHR + F.tid; i < D * ZLD / 4; i += F.G * NTHR) { const f32x4 v = __builtin_nontemporal_load(a + i); am = fmaxf(fmaxf(am, fmaxf(fabsf(v[0]), fabsf(v[1]))), fmaxf(fabsf(v[2]), fabsf(v[3]))); }
        for (int i = F.bid * NTHR + F.tid; i < D * GLD / 4; i += F.G * NTHR) { const f32x4 v = __builtin_nontemporal_load(b + i); am = fmaxf(fmaxf(am, fmaxf(fabsf(v[0]), fabsf(v[1]))), fmaxf(fabsf(v[2]), fabsf(v[3]))); }
        am = wave_max(am);
        if (F.lane == 0) atomicMax(WSP(unsigned, WS_CTL) + CW_WMAX + l * 64, __float_as_uint(am));
    }
}
__device__ __forceinline__ void transpose_item(const float* W, int K, int N, bf16_t* WT, int row_off, int imode, LAS float* scr, int item, int lane) {
    const int nblk = N / 64, kb = item / nblk, nb = item % nblk, k0 = 64 * kb, n0 = 64 * nb;
    const int q = lane & 15, r = lane >> 4;
    f32x4 v[16];
#pragma unroll
    for (int i = 0; i < 16; ++i) v[i] = __builtin_nontemporal_load((const f32x4*)(W + (size_t)(k0 + 4 * i + r) * N + n0 + 4 * q));
#pragma unroll
    for (int i = 0; i < 16; ++i) { LAS float* d = scr + (4 * i + r) * 65 + 4 * q; d[0] = v[i][0]; d[1] = v[i][1]; d[2] = v[i][2]; d[3] = v[i][3]; }
    LDS_WAIT(); asm volatile("" ::: "memory");
    const int c = lane & 7;
#pragma unroll
    for (int j = 0; j < 8; ++j) { const int n = (lane >> 3) + 8 * j; const LAS float* s_ = scr + (8 * c) * 65 + n;
        u32x4 o; o.x = cvtpk(s_[0 * 65], s_[1 * 65]); o.y = cvtpk(s_[2 * 65], s_[3 * 65]); o.z = cvtpk(s_[4 * 65], s_[5 * 65]); o.w = cvtpk(s_[6 * 65], s_[7 * 65]);
        const int ng = n0 + n; const int drow = (imode == 0) ? ng : ((ng >> 7) * 256 + (ng & 127) + (imode == 2 ? 128 : 0));
        *(u32x4*)(WT + (size_t)(row_off + drow) * K + k0 + 8 * c) = o; }
    LDS_WAIT(); asm volatile("" ::: "memory");
}
__device__ __forceinline__ void convert_weights(Frame& F, int l, int part) {
    LAS float* scr = (LAS float*)(F.lds + F.wave * 17408);
    constexpr int I_IN = 16 * 44, I_G = 16 * 64, I_B = 4 * 16, I_O = 16 * 16, I_1 = 16 * 8, I_2 = 8 * 16;
    constexpr int N0 = I_IN + I_G + 4 * I_B + I_O, N1 = 16 * 2 * I_1, N2 = 16 * I_2;
    bf16_t* WIN = WSP(bf16_t, WS_WIN); bf16_t* WB = WSP(bf16_t, WS_WB); bf16_t* WO = WSP(bf16_t, WS_WO); bf16_t* W13 = WSP(bf16_t, WS_W13); bf16_t* W2 = WSP(bf16_t, WS_W2);
    const int nitems = (part == 0) ? N0 : (part == 1) ? N1 : N2;
    const float wq = 127.f / fmaxf(__uint_as_float(__hip_atomic_load(WSP(unsigned, WS_CTL) + CW_WMAX + l * 64, __ATOMIC_RELAXED, __HIP_MEMORY_SCOPE_AGENT)), 1e-20f);
    const float wq13 = 127.f / fmaxf(__uint_as_float(__hip_atomic_load(WSP(unsigned, WS_CTL) + CW_WMAX13 + l * 64, __ATOMIC_RELAXED, __HIP_MEMORY_SCOPE_AGENT)), 1e-20f);
    for (int it = F.gw; it < nitems; it += F.NGW) {
        int r = it;
        if (part == 0) {
            if (r < I_IN) { transpose_item_i8(F.in[8] + (size_t)l * D * ZLD, D, ZLD, (unsigned char*)WIN, wq, scr, r, F.lane); continue; } r -= I_IN;
            if (r < I_G) { transpose_item_i8(F.in[21] + (size_t)l * D * GLD, D, GLD, (unsigned char*)WIN + (size_t)ZLD * D, wq, scr, r, F.lane); continue; } r -= I_G;
            if (r < 4 * I_B) { const int i = r / I_B; transpose_item(F.in[23] + ((size_t)l * 4 + i) * 256 * D, 256, D, WB + (size_t)i * 1024 * 256, 0, 0, scr, r % I_B, F.lane); continue; } r -= 4 * I_B;
            transpose_item(F.in[24] + (size_t)l * D * D, D, D, WO, 0, 0, scr, r, F.lane);
        } else if (part == 1) {
            const int e = r / (2 * I_1); r -= e * (2 * I_1);
            if (r < I_1) transpose_item_i8(F.in[27] + ((size_t)l * NE + e) * D * FFE, D, FFE, (unsigned char*)W13 + (size_t)e * 1024 * 1024, wq13, scr, r, F.lane, 1);
            else transpose_item_i8(F.in[28] + ((size_t)l * NE + e) * D * FFE, D, FFE, (unsigned char*)W13 + (size_t)e * 1024 * 1024, wq13, scr, r - I_1, F.lane, 2);
        } else {
            const int e = r / I_2; r -= e * I_2;
            transpose_item_fp8(F.in[29] + ((size_t)l * NE + e) * FFE * D, FFE, D, (unsigned char*)W2 + (size_t)e * 1024 * 512, 32.f, scr, r, F.lane);
        }
    }
}
__device__ __forceinline__ void mod_items(Frame& F) {
    float* modp = WSP(float, WS_MODP);
    for (int item = F.gw; item < 2 * 96 * 8; item += F.NGW) {
        const int kg = item & 7, cc = item >> 3, l = cc / 96, c0 = (cc % 96) * 64, col = c0 + F.lane, k0 = kg * 128;
        const float* w = F.in[4] + (size_t)l * D * 6144 + col;
        float s0 = 0.f, s1 = 0.f;
#pragma unroll 1
        for (int kb = 0; kb < 128; kb += 32) {
            float wv[32];
#pragma unroll
            for (int k = 0; k < 32; ++k) wv[k] = w[(size_t)(k0 + kb + k) * 6144];
#pragma unroll
            for (int k = 0; k < 32; ++k) { s0 += siluf_(F.in[1][k0 + kb + k]) * wv[k]; s1 += siluf_(F.in[3][k0 + kb + k]) * wv[k]; }
        }
        modp[(((size_t)kg * 2 + l) * 2 + 0) * 6144 + col] = s0; modp[(((size_t)kg * 2 + l) * 2 + 1) * 6144 + col] = s1;
    }
}
__device__ __forceinline__ float modv_reduce(Frame& F, int l, int v, int idx) {
    const float* modp = WSP(float, WS_MODP); float s = F.in[5][(size_t)l * 6144 + idx];
#pragma unroll
    for (int kg = 0; kg < 8; ++kg) s += modp[(((size_t)kg * 2 + l) * 2 + v) * 6144 + idx];
    return s;
}
__device__ __forceinline__ void rope_table(Frame& F) {
    if (F.bid != F.G - 1) return;
    float* tab = WSP(float, WS_ROPE);
    for (int idx = F.tid; idx < 256 * 8; idx += NTHR) {
        const int pos = idx >> 3, i = idx & 7;
        const float inv = (i == 0) ? 1.0f : (i == 1) ? 0.31622776601683794f : (i == 2) ? 0.1f : (i == 3) ? 0.031622776601683794f : (i == 4) ? 0.01f : (i == 5) ? 0.0031622776601683794f : (i == 6) ? 0.001f : 0.00031622776601683794f;
        const float a = (float)pos * inv;
        const float q = rintf(a * 0.6366197723675814f);
        const float r = ((a - q * 1.5703125f) - q * 4.837512969970703125e-4f) - q * 7.54978995489188e-8f;
        const float r2 = r * r;
        const float sn = r + r * r2 * (-1.6666667e-1f + r2 * (8.3333333e-3f + r2 * (-1.984127e-4f + r2 * 2.7557319e-6f)));
        const float cs = 1.0f + r2 * (-0.5f + r2 * (4.1666667e-2f + r2 * (-1.3888889e-3f + r2 * (2.4801587e-5f + r2 * -2.7557319e-7f))));
        const int qi = ((int)q) & 3;
        const float c = (qi == 0) ? cs : (qi == 1) ? -sn : (qi == 2) ? -cs : sn;
        const float s = (qi == 0) ? sn : (qi == 1) ? cs : (qi == 2) ? -sn : -cs;
        tab[pos * 16 + i] = c; tab[pos * 16 + 8 + i] = s;
    }
}

__device__ __forceinline__ void load_row(const float* p, f32x4 (&v)[4], int lane) {
#pragma unroll
    for (int j = 0; j < 4; ++j) v[j] = ((const f32x4*)p)[lane + 64 * j];
}
__device__ __forceinline__ void store_row(float* p, const f32x4 (&v)[4], int lane) {
#pragma unroll
    for (int j = 0; j < 4; ++j) ((f32x4*)p)[lane + 64 * j] = v[j];
}
__device__ __forceinline__ void store_row_bf16(bf16_t* p, const f32x4 (&v)[4], int lane) {
#pragma unroll
    for (int j = 0; j < 4; ++j) { u32x2 w; w.x = cvtpk(v[j][0], v[j][1]); w.y = cvtpk(v[j][2], v[j][3]); ((u32x2*)p)[lane + 64 * j] = w; }
}
__device__ __forceinline__ void store_row_fp8(unsigned char* p, const f32x4 (&v)[4], int lane) {
#pragma unroll
    for (int j = 0; j < 4; ++j) ((unsigned*)p)[lane + 64 * j] = pk4_fp8(v[j][0], v[j][1], v[j][2], v[j][3]);
}
__device__ __forceinline__ float store_row_i8(unsigned char* p, const f32x4 (&v)[4], int lane) {
    float am = 0.f;
#pragma unroll
    for (int j = 0; j < 4; ++j) am = fmaxf(fmaxf(am, fmaxf(fabsf(v[j][0]), fabsf(v[j][1]))), fmaxf(fabsf(v[j][2]), fabsf(v[j][3])));
    am = fmaxf(wave_max(am), 1e-20f);
    const float q = 127.f / am;
#pragma unroll
    for (int j = 0; j < 4; ++j) ((unsigned*)p)[lane + 64 * j] = pk4_i8(v[j][0] * q, v[j][1] * q, v[j][2] * q, v[j][3] * q);
    return am * (1.f / 127.f);
}
__device__ __forceinline__ float row_rms(const f32x4 (&v)[4]) {
    float s = 0.f;
#pragma unroll
    for (int j = 0; j < 4; ++j) s += (v[j][0] * v[j][0] + v[j][1] * v[j][1]) + (v[j][2] * v[j][2] + v[j][3] * v[j][3]);
    return __builtin_amdgcn_rsqf(wave_sum(s) * (1.f / D) + EPS);
}
__device__ __forceinline__ void moe_combine(Frame& F, int row, const float* g5, f32x4 (&x)[4]) {
    const int* R = WSP(int, WS_ROUTE);
    const int pa = R[5 * MT + row], pb = R[6 * MT + row]; const float wa = __int_as_float(R[3 * MT + row]), wb = __int_as_float(R[4 * MT + row]);
    const bf16_t* Ys = WSP(bf16_t, WS_Z);
#pragma unroll
    for (int j = 0; j < 4; ++j) {
        const u32x2 a = ((const u32x2*)(Ys + (size_t)pa * D))[F.lane + 64 * j], b = ((const u32x2*)(Ys + (size_t)pb * D))[F.lane + 64 * j];
        const f32x4 g = ((const f32x4*)g5)[F.lane + 64 * j];
        x[j][0] += g[0] * (wa * bflo(a.x) + wb * bflo(b.x)); x[j][1] += g[1] * (wa * bfhi(a.x) + wb * bfhi(b.x));
        x[j][2] += g[2] * (wa * bflo(a.y) + wb * bflo(b.y)); x[j][3] += g[3] * (wa * bfhi(a.y) + wb * bfhi(b.y));
    }
}
template <int MODE, int NB>
__device__ __forceinline__ void rows_batched(Frame& F, const float* xin, float* xio, bf16_t* H, const f32x4 (&ca)[4], const f32x4 (&cb)[4], const float* g5, int r0, int r1, int rbase, bool isdup) {
    const int* R = WSP(int, WS_ROUTE); const bf16_t* Ys = WSP(bf16_t, WS_Z);
    for (int row0 = r0 + F.gw; row0 < r1; row0 += NB * F.NGW) {
        f32x4 x[NB][4]; u32x2 ya[NB][4], yb[NB][4]; float wa[NB], wb[NB];
#pragma unroll
        for (int k = 0; k < NB; ++k) { const int row = row0 + k * F.NGW; if (row < r1) {
            if (MODE == 0) {
#pragma unroll
                for (int j = 0; j < 4; ++j) x[k][j] = __builtin_nontemporal_load((const f32x4*)(xin + (size_t)(row - rbase) * D) + F.lane + 64 * j);
            } else load_row((const float*)xio + (size_t)(row - rbase) * D, x[k], F.lane);
            if (MODE != 0) { const int ee_ = R[0 * MT + row]; const int* pst_ = WSP(int, WS_META) + 256; const int pa = pst_[ee_ & 255] + R[1 * MT + row], pb = pst_[ee_ >> 8] + R[2 * MT + row]; wa[k] = __int_as_float(R[3 * MT + row]); wb[k] = __int_as_float(R[4 * MT + row]);
#pragma unroll
                for (int j = 0; j < 4; ++j) { ya[k][j] = ((const u32x2*)(Ys + (size_t)pa * D))[F.lane + 64 * j]; yb[k][j] = ((const u32x2*)(Ys + (size_t)pb * D))[F.lane + 64 * j]; } } } }
#pragma unroll
        for (int k = 0; k < NB; ++k) { const int row = row0 + k * F.NGW; if (row < r1) {
            if (MODE != 0) {
#pragma unroll
                for (int j = 0; j < 4; ++j) { const f32x4 g = ((const f32x4*)g5)[F.lane + 64 * j]; const u32x2 a = ya[k][j], b = yb[k][j];
                    x[k][j][0] += g[0] * (wa[k] * bflo(a.x) + wb[k] * bflo(b.x)); x[k][j][1] += g[1] * (wa[k] * bfhi(a.x) + wb[k] * bfhi(b.x));
                    x[k][j][2] += g[2] * (wa[k] * bflo(a.y) + wb[k] * bflo(b.y)); x[k][j][3] += g[3] * (wa[k] * bfhi(a.y) + wb[k] * bfhi(b.y)); }
                if (MODE == 1 && !isdup) store_row(xio + (size_t)(row - rbase) * D, x[k], F.lane);
            }
            const float rs = row_rms(x[k]);
            if (MODE == 2) {
#pragma unroll
                for (int j = 0; j < 4; ++j) x[k][j] = x[k][j] * rs * ca[j];
                store_row((isdup ? WSP(float, WS_G) : xio) + (size_t)(row - rbase) * D, x[k], F.lane);
            } else {
#pragma unroll
                for (int j = 0; j < 4; ++j) x[k][j] = x[k][j] * rs * ca[j] + cb[j];
                { const float hs_ = store_row_i8(WSP(unsigned char, WS_H8) + (size_t)row * D, x[k], F.lane); if (F.lane == 0) WSP(float, WS_HS)[row] = hs_; }
            }
        } }
    }
}
__device__ __forceinline__ void norm1_phase(Frame& F, int l, bool isdup) {
    float* modv = WSP(float, WS_MODV); bf16_t* H = isdup ? WSP(bf16_t, WS_G) : WSP(bf16_t, WS_H); float* XC = WSP(float, WS_XC);
    if (l == 0 && !isdup) for (int idx = F.bid * NTHR + F.tid; idx < 2 * 2 * 6144; idx += F.G * NTHR) modv[idx] = modv_reduce(F, idx / 12288, (idx / 6144) & 1, idx % 6144);
    for (int v = 0; v < 2; ++v) {
        const float* mv = modv + ((size_t)l * 2 + v) * 6144; const float* mvp = modv + ((size_t)(l > 0 ? l - 1 : 0) * 2 + v) * 6144;
        f32x4 ca[4], cb[4];
#pragma unroll
        for (int j = 0; j < 4; ++j) { const f32x4 g = ((const f32x4*)(F.in[6] + (size_t)l * D))[F.lane + 64 * j]; f32x4 sh, sc;
            if (l == 0) {
#pragma unroll
                for (int e = 0; e < 4; ++e) { sh[e] = modv_reduce(F, 0, v, 4 * (F.lane + 64 * j) + e); sc[e] = modv_reduce(F, 0, v, D + 4 * (F.lane + 64 * j) + e); }
            } else { sh = ((const f32x4*)mv)[F.lane + 64 * j]; sc = ((const f32x4*)(mv + D))[F.lane + 64 * j]; }
            ca[j] = g * (sc + 1.f); cb[j] = sh; }
        const int r0 = v ? SEQ : 0, r1 = v ? MT : SEQ;
        if (l == 0) rows_batched<0, 4>(F, v ? F.in[2] : F.in[0], nullptr, H, ca, cb, nullptr, r0, r1, r0, isdup);
        else rows_batched<1, 4>(F, nullptr, v ? XC : F.out, H, ca, cb, mvp + 5 * D, r0, r1, r0, isdup);
    }
}
__device__ __forceinline__ void final_phase(Frame& F, bool isdup) {
    const float* mvp = WSP(float, WS_MODV) + ((size_t)1 * 2 + 0) * 6144;
    f32x4 gf[4];
#pragma unroll
    for (int j = 0; j < 4; ++j) gf[j] = ((const f32x4*)F.in[30])[F.lane + 64 * j];
    rows_batched<2, 4>(F, nullptr, F.out, nullptr, gf, gf, mvp + 5 * D, 0, SEQ, 0, isdup);
}
__device__ __forceinline__ void route_phase(Frame& F, int l, bool isdup, const unsigned* wo_cnt) {
    LAS float* wrT = (LAS float*)F.lds;
    LAS unsigned* lcnt = (LAS unsigned*)(F.lds + 65536); LAS unsigned* lbase = lcnt + 16; LAS unsigned* lrec = lcnt + 32;
    if (F.tid < NE) lcnt[F.tid] = 0u;
    int nloc = 0;
    {
        f32x4 wv[8];
#pragma unroll
        for (int i = 0; i < 8; ++i) wv[i] = ((const f32x4*)F.in[25])[F.tid + NTHR * i];
#pragma unroll
        for (int i = 0; i < 8; ++i) { const int i4 = F.tid + NTHR * i, col = i4 >> 2, e0 = (i4 & 3) * 4;
            wrT[(e0 + 0) * D + col] = wv[i][0]; wrT[(e0 + 1) * D + col] = wv[i][1]; wrT[(e0 + 2) * D + col] = wv[i][2]; wrT[(e0 + 3) * D + col] = wv[i][3]; }
    }
    __syncthreads();
    const float* modv = WSP(float, WS_MODV); bf16_t* H2 = WSP(bf16_t, WS_H); float* XC = WSP(float, WS_XC);
    int* R = WSP(int, WS_ROUTE) + (isdup ? 8 * MT : 0); unsigned* cnt = WSP(unsigned, WS_CTL) + CW_CNT + l * 2048 + (isdup ? 1024 : 0);
    const float brl = F.in[26][F.lane >> 2];
    const int nunits = (l == 1) ? SEQ / 64 : MT / 64;
#pragma unroll 1
    for (int unit = F.bid; unit < nunits; unit += F.G) {
        const int v = (unit >= SEQ / 64) ? 1 : 0, rb = unit * 64;
        if (F.tid < 64) { unsigned sp = 0;
            while ((unsigned)__builtin_amdgcn_readfirstlane(__hip_atomic_load(wo_cnt + 64 * (unit >> 2), __ATOMIC_RELAXED, __HIP_MEMORY_SCOPE_AGENT)) < 32u) { __builtin_amdgcn_s_sleep(2); if (++sp > (1u << 22)) break; }
            __builtin_amdgcn_fence(__ATOMIC_ACQUIRE, "agent");
            asm volatile("s_waitcnt vmcnt(0)" ::: "memory"); }
        __syncthreads();
        const float* mv = modv + ((size_t)l * 2 + v) * 6144;
        f32x4 ca[4], cb[4];
#pragma unroll
        for (int j = 0; j < 4; ++j) { const f32x4 g = ((const f32x4*)(F.in[7] + (size_t)l * D))[F.lane + 64 * j], sh = ((const f32x4*)(mv + 3 * D))[F.lane + 64 * j], sc = ((const f32x4*)(mv + 4 * D))[F.lane + 64 * j];
            ca[j] = g * (sc + 1.f); cb[j] = sh; }
        const float* src = v ? XC + (size_t)(rb - SEQ) * D : F.out + (size_t)rb * D;
        f32x4 xn[4];
        load_row(src + (size_t)F.wave * D, xn, F.lane);
#pragma unroll 1
        for (int k = 0; k < 8; ++k) {
            const int row = rb + F.wave + 8 * k;
            f32x4 x[4];
#pragma unroll
            for (int j = 0; j < 4; ++j) x[j] = xn[j];
            if (k < 7) load_row(src + (size_t)(F.wave + 8 * (k + 1)) * D, xn, F.lane);
            const float rs = row_rms(x);
#pragma unroll
            for (int j = 0; j < 4; ++j) x[j] = x[j] * rs * ca[j] + cb[j];
            const float h2s = store_row_i8(WSP(unsigned char, WS_H2I) + (size_t)row * D, x, F.lane);
            float p[NE];
#pragma unroll
            for (int eg = 0; eg < NE; eg += 4) {
                f32x4 w[4][4];
#pragma unroll
                for (int q = 0; q < 4; ++q)
#pragma unroll
                    for (int j = 0; j < 4; ++j) w[q][j] = *(const LAS f32x4*)(wrT + (eg + q) * D + 4 * F.lane + 256 * j);
#pragma unroll
                for (int q = 0; q < 4; ++q) p[eg + q] = 0.f;
#pragma unroll
                for (int j = 0; j < 4; ++j)
#pragma unroll
                    for (int c = 0; c < 4; ++c)
#pragma unroll
                        for (int q = 0; q < 4; ++q) p[eg + q] = __builtin_fmaf(x[j][c], w[q][j][c], p[eg + q]);
                asm volatile("" ::: "memory");
            }
            float sg[NE], sb[NE];
            {
                const float z = wave_sum16(p, F.lane);
                const float sgl = __builtin_amdgcn_rcpf(1.f + __builtin_amdgcn_exp2f(z * -1.4426950408889634f)), sbl = sgl + brl;
#pragma unroll
                for (int e = 0; e < NE; ++e) { sg[e] = __int_as_float(__builtin_amdgcn_readlane(__float_as_int(sgl), 4 * e)); sb[e] = __int_as_float(__builtin_amdgcn_readlane(__float_as_int(sbl), 4 * e)); }
            }
            float best = -INFINITY; int e1 = 0, e2 = 1; float s1 = 0.f, s2 = 0.f;
#pragma unroll
            for (int g = 0; g < 4; ++g) {
                int a = 0; float va = sb[4 * g];
#pragma unroll
                for (int k = 1; k < 4; ++k) if (sb[4 * g + k] > va) { va = sb[4 * g + k]; a = k; }
                int b = -1; float vb = -INFINITY;
#pragma unroll
                for (int k = 0; k < 4; ++k) if (k != a && sb[4 * g + k] > vb) { vb = sb[4 * g + k]; b = k; }
                const float gs = va + vb;
                if (gs > best) { best = gs; e1 = 4 * g + a; e2 = 4 * g + b;
                    float sa_ = 0.f, sb_ = 0.f;
#pragma unroll
                    for (int k = 0; k < 4; ++k) { if (k == a) sa_ = sg[4 * g + k]; if (k == b) sb_ = sg[4 * g + k]; }
                    s1 = sa_; s2 = sb_; }
            }
            if (F.lane == 0) {
                const float inv = 1.f / (s1 + s2);
                const unsigned la = __hip_atomic_fetch_add(lcnt + e1, 1u, __ATOMIC_RELAXED, __HIP_MEMORY_SCOPE_WORKGROUP), lb = __hip_atomic_fetch_add(lcnt + e2, 1u, __ATOMIC_RELAXED, __HIP_MEMORY_SCOPE_WORKGROUP);
                const int k = nloc++;
                lrec[(F.wave * 40 + k) * 4 + 0] = (unsigned)row; lrec[(F.wave * 40 + k) * 4 + 1] = (unsigned)(e1 | (e2 << 8)) | (la << 16); lrec[(F.wave * 40 + k) * 4 + 2] = lb; lrec[(F.wave * 40 + k) * 4 + 3] = __float_as_uint(h2s);
                R[3 * MT + row] = __float_as_int(s1 * inv); R[4 * MT + row] = __float_as_int(s2 * inv);
            }
        }
    }
    __syncthreads();
    if (F.tid < NE) lbase[F.tid] = atomicAdd(cnt + F.tid * 64, lcnt[F.tid]);
    __syncthreads();
    if (F.lane == 0) {
        for (int k = 0; k < nloc; ++k) {
            const unsigned row = lrec[(F.wave * 40 + k) * 4 + 0], w1 = lrec[(F.wave * 40 + k) * 4 + 1], lb = lrec[(F.wave * 40 + k) * 4 + 2];
            const unsigned ea = w1 & 255u, eb = (w1 >> 8) & 255u, la = w1 >> 16;
            R[0 * MT + row] = (int)(ea | (eb << 8)); R[1 * MT + row] = (int)(lbase[ea] + la); R[2 * MT + row] = (int)(lbase[eb] + lb);
            if (!isdup) { unsigned short* inv = WSP(unsigned short, WS_INV); inv[(size_t)ea * MT + lbase[ea] + la] = (unsigned short)row; inv[(size_t)eb * MT + lbase[eb] + lb] = (unsigned short)row;
                const unsigned hsb = lrec[(F.wave * 40 + k) * 4 + 3]; unsigned* hss = WSP(unsigned, WS_HSS); hss[(size_t)ea * MT + lbase[ea] + la] = hsb; hss[(size_t)eb * MT + lbase[eb] + lb] = hsb; }
        }
    }
    __syncthreads();
}
__device__ __forceinline__ void conv_a_tile(Frame& F, int l, int tile) {
    const bf16_t* Z = WSP(bf16_t, WS_Z); bf16_t* Y = WSP(bf16_t, WS_Y);
    LAS float* U = (LAS float*)F.lds;
    const int t0 = tile * 64, s0 = (tile < 256) ? 0 : SEQ, s1 = (tile < 256) ? SEQ : MT;
    {
        const int c8 = (F.tid & 31) * 8, rb = F.tid >> 5;
        u32x4 av[6], gv[6];
#pragma unroll
        for (int i = 0; i < 6; ++i) { const int r = rb + 16 * i, t = t0 - 15 + r; const bool ok = (r < 94) && (t >= s0) && (t < s1);
            av[i] = (u32x4){0u, 0u, 0u, 0u}; gv[i] = av[i];
            if (ok) { av[i] = *(const u32x4*)(Z + (size_t)t * ZLD + ZC_CONF + c8); gv[i] = *(const u32x4*)(Z + (size_t)t * ZLD + ZC_CONF + 256 + c8); } }
#pragma unroll
        for (int i = 0; i < 6; ++i) { const int r = rb + 16 * i; if (r < 94) { const u32x4 a = av[i], g = gv[i]; f32x4 u0, u1;
            u0[0] = bflo(a.x) * sigmoidf_(bflo(g.x)); u0[1] = bfhi(a.x) * sigmoidf_(bfhi(g.x)); u0[2] = bflo(a.y) * sigmoidf_(bflo(g.y)); u0[3] = bfhi(a.y) * sigmoidf_(bfhi(g.y));
            u1[0] = bflo(a.z) * sigmoidf_(bflo(g.z)); u1[1] = bfhi(a.z) * sigmoidf_(bfhi(g.z)); u1[2] = bflo(a.w) * sigmoidf_(bflo(g.w)); u1[3] = bfhi(a.w) * sigmoidf_(bfhi(g.w));
            *(LAS f32x4*)(U + r * 256 + c8) = u0; *(LAS f32x4*)(U + r * 256 + c8 + 4) = u1; } }
    }
    __syncthreads();
    const int c = F.tid & 255, hf = F.tid >> 8;
    float uw[62];
#pragma unroll
    for (int i = 0; i < 62; ++i) uw[i] = U[(hf * 32 + i) * 256 + c];
    __syncthreads();
    float acc[32]; const float bias = F.in[10][l * 256 + c];
#pragma unroll
    for (int t = 0; t < 32; ++t) acc[t] = bias;
    const float* w = F.in[9] + (size_t)l * 31 * 256 + c;
    float wk[31];
#pragma unroll
    for (int k = 0; k < 31; ++k) wk[k] = w[k * 256];
#pragma unroll
    for (int k = 0; k < 31; ++k) {
#pragma unroll
        for (int t = 0; t < 32; ++t) acc[t] += wk[k] * uw[t + k]; }
#pragma unroll
    for (int t = 0; t < 32; ++t) U[(hf * 32 + t) * 256 + c] = acc[t];
    __syncthreads();
    const f32x4 gn = ((const f32x4*)(F.in[11] + l * 256))[F.lane], bn = ((const f32x4*)(F.in[12] + l * 256))[F.lane];
    for (int t = F.wave; t < 64; t += NWAVES) {
        const f32x4 v = *(const LAS f32x4*)(U + t * 256 + 4 * F.lane);
        const float mean = wave_sum((v[0] + v[1]) + (v[2] + v[3])) * (1.f / 256.f);
        const f32x4 d = v - mean;
        const float var = wave_sum((d[0] * d[0] + d[1] * d[1]) + (d[2] * d[2] + d[3] * d[3])) * (1.f / 256.f);
        const float rstd = __builtin_amdgcn_rsqf(var + EPS);
        f32x4 y = d * rstd * gn + bn;
#pragma unroll
        for (int e = 0; e < 4; ++e) y[e] = siluf_(y[e]);
        u32x2 o; o.x = cvtpk(y[0], y[1]); o.y = cvtpk(y[2], y[3]);
        *(u32x2*)(Y + (size_t)(t0 + t) * D + 0 + 4 * F.lane) = o;
    }
    __syncthreads();
}
__device__ __forceinline__ void conv_b_items(Frame& F, int l) {
    const bf16_t* Z = WSP(bf16_t, WS_Z); bf16_t* Y = WSP(bf16_t, WS_Y);
    const float* w = F.in[13] + (size_t)l * 3 * 256;
    const int nrow = (l == 1) ? SEQ : MT;
    for (int idx = F.bid * NTHR + F.tid; idx < nrow * 32; idx += F.G * NTHR) {
        const int t = idx >> 5, c8 = (idx & 31) * 8, s0 = (t < SEQ) ? 0 : SEQ, s1 = (t < SEQ) ? SEQ : MT;
        float acc[8];
#pragma unroll
        for (int e = 0; e < 8; ++e) acc[e] = 0.f;
#pragma unroll
        for (int k = 0; k < 3; ++k) { const int tt = t + k - 1; if (tt < s0 || tt >= s1) continue;
            const u32x4 cg = *(const u32x4*)(Z + (size_t)tt * ZLD + ZC_SC + 256 + c8), xv = *(const u32x4*)(Z + (size_t)tt * ZLD + ZC_SC + 512 + c8);
            const f32x4 w0 = *(const f32x4*)(w + k * 256 + c8), w1 = *(const f32x4*)(w + k * 256 + c8 + 4);
            acc[0] += w0[0] * bflo(cg.x) * bflo(xv.x); acc[1] += w0[1] * bfhi(cg.x) * bfhi(xv.x); acc[2] += w0[2] * bflo(cg.y) * bflo(xv.y); acc[3] += w0[3] * bfhi(cg.y) * bfhi(xv.y);
            acc[4] += w1[0] * bflo(cg.z) * bflo(xv.z); acc[5] += w1[1] * bfhi(cg.z) * bfhi(xv.z); acc[6] += w1[2] * bflo(cg.w) * bflo(xv.w); acc[7] += w1[3] * bfhi(cg.w) * bfhi(xv.w); }
        const u32x4 bg = *(const u32x4*)(Z + (size_t)t * ZLD + ZC_SC + c8);
        u32x4 o; o.x = cvtpk(acc[0] * bflo(bg.x), acc[1] * bfhi(bg.x)); o.y = cvtpk(acc[2] * bflo(bg.y), acc[3] * bfhi(bg.y));
        o.z = cvtpk(acc[4] * bflo(bg.z), acc[5] * bfhi(bg.z)); o.w = cvtpk(acc[6] * bflo(bg.w), acc[7] * bfhi(bg.w));
        *(u32x4*)(Y + (size_t)t * D + 256 + c8) = o;
    }
}
__device__ __forceinline__ void kmax_items(Frame& F, int l) {
    const bf16_t* Z = WSP(bf16_t, WS_Z); unsigned* tab = WSP(unsigned, WS_CTL) + CW_KMAX + l * 260 * 8;
    for (int it = F.gw; it < 260 * 8; it += F.NGW) {
        const int t = it >> 3, hm = it & 7;
        const bf16_t* kr = Z + (size_t)(t * 64 + F.lane) * ZLD + ZC_DK + hm * 32;
        float ss = 0.f;
#pragma unroll
        for (int c = 0; c < 4; ++c) { const u32x4 a = *(const u32x4*)(kr + c * 8);
            ss += bflo(a.x) * bflo(a.x) + bfhi(a.x) * bfhi(a.x) + bflo(a.y) * bflo(a.y) + bfhi(a.y) * bfhi(a.y) + bflo(a.z) * bflo(a.z) + bfhi(a.z) * bfhi(a.z) + bflo(a.w) * bflo(a.w) + bfhi(a.w) * bfhi(a.w); }
        ss = wave_max(ss);
        if (F.lane == 0) { atomicMax(tab + it, __float_as_uint(ss)); atomicMax(WSP(unsigned, WS_CTL) + CW_KMAXG + l * 8 + hm, __float_as_uint(ss)); }
    }
}
__device__ __forceinline__ void ret_kv_unit(Frame& F, int l, int unit) {
    const int n = unit >> 2, h = unit & 3;
    const bf16_t* Z = WSP(bf16_t, WS_Z); float* KV = WSP(float, WS_KV);
    LAS float* ks = (LAS float*)F.lds;
    LAS float* vs = ks + 128 * 32;
    for (int idx = F.tid; idx < 128 * 4; idx += NTHR) { const int j = idx >> 2, c8 = (idx & 3) * 8; const u32x4 a = *(const u32x4*)(Z + (size_t)(n * 128 + j) * ZLD + ZC_RK + h * 32 + c8);
        LAS float* p = ks + j * 32 + c8; p[0] = bflo(a.x); p[1] = bfhi(a.x); p[2] = bflo(a.y); p[3] = bfhi(a.y); p[4] = bflo(a.z); p[5] = bfhi(a.z); p[6] = bflo(a.w); p[7] = bfhi(a.w); }
    for (int idx = F.tid; idx < 128 * 8; idx += NTHR) { const int j = idx >> 3, c8 = (idx & 7) * 8; const u32x4 a = *(const u32x4*)(Z + (size_t)(n * 128 + j) * ZLD + ZC_RV + h * 64 + c8);
        LAS float* p = vs + j * 64 + c8; p[0] = bflo(a.x); p[1] = bfhi(a.x); p[2] = bflo(a.y); p[3] = bfhi(a.y); p[4] = bflo(a.z); p[5] = bfhi(a.z); p[6] = bflo(a.w); p[7] = bfhi(a.w); }
    __syncthreads();
    const int dir = F.wave >> 2, d = F.lane & 31, e0 = (F.wave & 3) * 16 + (F.lane >> 5) * 8;
    const float lg2 = (dir ? F.in[20][l * 4 + h] : F.in[19][l * 4 + h]) * 1.4426950408889634f;
    float acc[8];
#pragma unroll
    for (int e = 0; e < 8; ++e) acc[e] = 0.f;
    for (int j = 0; j < 128; ++j) {
        const float dec = __builtin_amdgcn_exp2f((dir ? (float)j : (float)(127 - j)) * lg2);
        const float kd = ks[j * 32 + d] * dec;
        const f32x4 v0 = *(const LAS f32x4*)(vs + j * 64 + e0), v1 = *(const LAS f32x4*)(vs + j * 64 + e0 + 4);
        acc[0] += kd * v0[0]; acc[1] += kd * v0[1]; acc[2] += kd * v0[2]; acc[3] += kd * v0[3]; acc[4] += kd * v1[0]; acc[5] += kd * v1[1]; acc[6] += kd * v1[2]; acc[7] += kd * v1[3];
    }
    float* o = KV + (((size_t)dir * NCH + n) * 4 + h) * 2048;
#pragma unroll
    for (int e = 0; e < 8; ++e) o[(e0 + e) * 32 + d] = acc[e];
    __syncthreads();
}
__device__ __forceinline__ void scan_publish(Frame& F, int l) {
    if (F.wave == 0) {
        for (int gid = F.bid * 64 + F.lane; gid < 2 * 4 * 2048; gid += F.G * 64) {
            const int dir = gid >> 13, h = (gid >> 11) & 3, idx = gid & 2047;
            const float* KV = WSP(float, WS_KV) + (size_t)dir * NCH * 4 * 2048 + h * 2048 + idx; bf16_t* SS = WSP(bf16_t, WS_SST) + (size_t)dir * NCH * 4 * 2048 + h * 2048 + idx;
            const float dec = expf(128.f * (dir ? F.in[20][l * 4 + h] : F.in[19][l * 4 + h]));
            float S = 0.f;
#pragma unroll 1
            for (int c0 = 0; c0 < NCH; c0 += 65) {
#define SCAN_NN(o_) (dir ? ((o_) == 0 ? 129 : (o_) == 1 ? 128 : NCH - 1 - (o_)) : ((o_) == 0 ? 128 : (o_) == 1 ? 129 : (o_) - 2))
                float kv[65];
#pragma unroll
                for (int c = 0; c < 65; ++c) kv[c] = KV[(size_t)SCAN_NN(c0 + c) * 8192];
#pragma unroll
                for (int c = 0; c < 65; ++c) { SS[(size_t)SCAN_NN(c0 + c) * 8192] = f2bf(S); S = dec * S + kv[c]; }
#undef SCAN_NN
            }
        }
        asm volatile("s_waitcnt vmcnt(0)" ::: "memory");
        if (F.lane == 0) { __builtin_amdgcn_fence(__ATOMIC_RELEASE, "agent"); asm volatile("s_waitcnt vmcnt(0)" ::: "memory");
            __hip_atomic_fetch_add(WSP(unsigned, WS_CTL) + CW_SCAN + l * 64, 1u, __ATOMIC_RELAXED, __HIP_MEMORY_SCOPE_AGENT); }
    }
}
__device__ __forceinline__ void scan_wait(Frame& F, int l) {
    if (F.wave == 0) {
        unsigned* c = WSP(unsigned, WS_CTL) + CW_SCAN + l * 64; unsigned sp = 0;
        while ((unsigned)__builtin_amdgcn_readfirstlane(__hip_atomic_load(c, __ATOMIC_RELAXED, __HIP_MEMORY_SCOPE_AGENT)) < (unsigned)F.G) { __builtin_amdgcn_s_sleep(4); if (++sp > (1u << 22)) break; }
        __builtin_amdgcn_fence(__ATOMIC_ACQUIRE, "agent");
        asm volatile("s_waitcnt vmcnt(0)" ::: "memory");
    }
    __syncthreads();
}

__device__ __forceinline__ float diff_lambda(Frame& F, int l, float lam_init);
namespace att {
typedef short s16x4 __attribute__((ext_vector_type(4)));
typedef short v4i16_t __attribute__((ext_vector_type(4)));
constexpr int SLOTB = 8192, LDS_K = 0, LDS_V = 2 * SLOTB;
constexpr float THR = 12.f;
__device__ __forceinline__ int crow(int r, int hi) { return (r & 3) + 8 * (r >> 2) + 4 * hi; }
__device__ __forceinline__ s16x4 vtr(const LAS unsigned char* p) { return __builtin_bit_cast(s16x4, __builtin_amdgcn_ds_read_tr16_b64_v4i16((LAS v4i16_t*)p)); }
__device__ __forceinline__ float half_max(float m) { auto rr = __builtin_amdgcn_permlane32_swap(__float_as_uint(m), __float_as_uint(m), false, false); return fmaxf(__uint_as_float(rr[0]), __uint_as_float(rr[1])); }
__device__ __forceinline__ float half_sum(float m) { auto rr = __builtin_amdgcn_permlane32_swap(__float_as_uint(m), __float_as_uint(m), false, false); return __uint_as_float(rr[0]) + __uint_as_float(rr[1]); }
__device__ __forceinline__ float sum32(float v) {
    v += dpp_f<0xB1>(v); v += dpp_f<0x4E>(v); v += dpp_f<0x141>(v); v += dpp_f<0x140>(v);
    auto rr = __builtin_amdgcn_permlane16_swap(__float_as_uint(v), __float_as_uint(v), false, false); return __uint_as_float(rr[0]) + __uint_as_float(rr[1]);
}
__device__ __forceinline__ float rowmax32(const f32x16& a, const f32x16& b) {
    float x = fmaxf(fmaxf(a[0], a[1]), b[0]), y = fmaxf(fmaxf(a[2], a[3]), b[1]); x = fmaxf(fmaxf(x, b[2]), b[3]);
#pragma unroll
    for (int r = 4; r < 16; r += 4) { x = fmaxf(fmaxf(x, a[r]), a[r + 1]); y = fmaxf(fmaxf(y, a[r + 2]), a[r + 3]); x = fmaxf(fmaxf(x, b[r]), b[r + 1]); y = fmaxf(fmaxf(y, b[r + 2]), b[r + 3]); }
    return half_max(fmaxf(x, y));
}
__device__ __forceinline__ void softmax_map(f32x16& sa, f32x16& sb, float& m, float& l, f32x16 (&o)[2], u32x4 (&pw)[4], int hi) {
    const float rm = rowmax32(sa, sb);
    if (__builtin_expect(__any(rm - m > THR), 0)) {
        const float mn = fmaxf(m, rm), f = __builtin_amdgcn_exp2f(m - mn); m = mn; l *= f;
        int hi_ = hi; asm volatile("" : "+v"(hi_));
#pragma unroll
        for (int r = 0; r < 16; ++r) { const float fr_ = __int_as_float(__builtin_amdgcn_ds_bpermute(4 * crow(r, hi_), __float_as_int(f))); o[0][r] *= fr_; o[1][r] *= fr_; }
    }
    float sum = 0.f;
#pragma unroll
    for (int r = 0; r < 16; ++r) { sa[r] = __builtin_amdgcn_exp2f(sa[r] - m); sb[r] = __builtin_amdgcn_exp2f(sb[r] - m); sum += sa[r] + sb[r]; }
    l += sum;
    pw[0] = (u32x4){cvtpk(sa[0], sa[1]), cvtpk(sa[2], sa[3]), cvtpk(sa[4], sa[5]), cvtpk(sa[6], sa[7])};
    pw[1] = (u32x4){cvtpk(sa[8], sa[9]), cvtpk(sa[10], sa[11]), cvtpk(sa[12], sa[13]), cvtpk(sa[14], sa[15])};
    pw[2] = (u32x4){cvtpk(sb[0], sb[1]), cvtpk(sb[2], sb[3]), cvtpk(sb[4], sb[5]), cvtpk(sb[6], sb[7])};
    pw[3] = (u32x4){cvtpk(sb[8], sb[9]), cvtpk(sb[10], sb[11]), cvtpk(sb[12], sb[13]), cvtpk(sb[14], sb[15])};
}
__device__ __forceinline__ void attn_unit(Frame& F, int l, int h, int q0, int k0, int nt, float lam, float lam_init) {
    const bf16_t* Z = WSP(bf16_t, WS_Z); bf16_t* Y = WSP(bf16_t, WS_Y);
    const int lane = F.lane, r32 = lane & 31, hi = lane >> 5, wid = F.wave;
    const bf16_t* Qw = Z + (size_t)(q0 + wid * 32) * ZLD + ZC_DQ + h * 64;
    const bf16_t* ksrc = Z + (size_t)(k0 + lane) * ZLD + ZC_DK + h * 64 + wid * 8;
    const bf16_t* vsrc = Z + (size_t)(k0 + 16 * (wid & 3) + (lane >> 2)) * ZLD + ZC_DV + h * 64 + (wid >> 2) * 32 + (lane & 3) * 8;
    LAS unsigned char* lds = F.lds;
    const unsigned lds0 = (unsigned)(size_t)lds;
#define ATT_GLDS(gsrc, dst) do { unsigned keep_; asm volatile("s_mov_b32 %0, m0\n\ts_mov_b32 m0, %2\n\ts_nop 0\n\tglobal_load_lds_dwordx4 %1, off\n\ts_mov_b32 m0, %0" : "=&s"(keep_) : "v"(gsrc), "s"(dst) : "memory"); } while (0)
#define ATT_DMA(t, slot) do { ATT_GLDS(ksrc + (size_t)(t) * 64 * ZLD, (unsigned)__builtin_amdgcn_readfirstlane(lds0 + LDS_K + (slot) * SLOTB + wid * 1024)); \
        ATT_GLDS(vsrc + (size_t)(t) * 64 * ZLD, (unsigned)__builtin_amdgcn_readfirstlane(lds0 + LDS_V + (slot) * SLOTB + wid * 1024)); } while (0)
    __syncthreads();
    ATT_DMA(0, 0);
    bf16x8 qr[4];
#pragma unroll
    for (int d0 = 0; d0 < 4; ++d0) qr[d0] = *(const bf16x8*)(Qw + (size_t)r32 * ZLD + d0 * 16 + hi * 8);
    f32x16 o1[2], o2[2];
#pragma unroll
    for (int r = 0; r < 16; ++r) { o1[0][r] = 0.f; o1[1][r] = 0.f; o2[0][r] = 0.f; o2[1][r] = 0.f; }
    float m1 = 0.f, m2 = 0.f, l1 = 0.f, l2 = 0.f;
    const int kfo = hi * 1024 + r32 * 16;
    const int vfo = ((lane >> 4) & 1) * 32 + (lane & 3) * 8 + (4 * hi + ((lane & 15) >> 2)) * 64;
    asm volatile("s_waitcnt vmcnt(0)" ::: "memory");
    __syncthreads();
    for (int t = 0; t < nt; ++t) {
        const int cur = t & 1;
        const LAS unsigned char* kp = lds + LDS_K + cur * SLOTB + kfo;
        const LAS unsigned char* vp = lds + LDS_V + cur * SLOTB + vfo;
        if (t + 1 < nt) ATT_DMA(t + 1, cur ^ 1);
        const f32x16 zero = {0.f, 0.f, 0.f, 0.f, 0.f, 0.f, 0.f, 0.f, 0.f, 0.f, 0.f, 0.f, 0.f, 0.f, 0.f, 0.f};
        u32x4 pw[4];
        bf16x8 kf[4];
#pragma unroll
        for (int d0 = 0; d0 < 2; ++d0) { kf[2 * d0] = *(const LAS bf16x8*)(kp + d0 * 2048); kf[2 * d0 + 1] = *(const LAS bf16x8*)(kp + d0 * 2048 + 512); }
        f32x16 sa = __builtin_amdgcn_mfma_f32_32x32x16_bf16(kf[0], qr[0], zero, 0, 0, 0); sa = __builtin_amdgcn_mfma_f32_32x32x16_bf16(kf[2], qr[1], sa, 0, 0, 0);
        f32x16 sb = __builtin_amdgcn_mfma_f32_32x32x16_bf16(kf[1], qr[0], zero, 0, 0, 0); sb = __builtin_amdgcn_mfma_f32_32x32x16_bf16(kf[3], qr[1], sb, 0, 0, 0);
#pragma unroll
        for (int d0 = 0; d0 < 2; ++d0) { kf[2 * d0] = *(const LAS bf16x8*)(kp + 4096 + d0 * 2048); kf[2 * d0 + 1] = *(const LAS bf16x8*)(kp + 4096 + d0 * 2048 + 512); }
        f32x16 ta = __builtin_amdgcn_mfma_f32_32x32x16_bf16(kf[0], qr[2], zero, 0, 0, 0); ta = __builtin_amdgcn_mfma_f32_32x32x16_bf16(kf[2], qr[3], ta, 0, 0, 0);
        f32x16 tb = __builtin_amdgcn_mfma_f32_32x32x16_bf16(kf[1], qr[2], zero, 0, 0, 0); tb = __builtin_amdgcn_mfma_f32_32x32x16_bf16(kf[3], qr[3], tb, 0, 0, 0);
        softmax_map(sa, sb, m1, l1, o1, pw, hi);
        bf16x8 vf[2][4];
#pragma unroll
        for (int d0 = 0; d0 < 2; ++d0)
#pragma unroll
            for (int ks = 0; ks < 4; ++ks) { const s16x4 lo = vtr(vp + d0 * 4096 + ks * 1024), hh = vtr(vp + d0 * 4096 + ks * 1024 + 512);
                vf[d0][ks] = (bf16x8){lo[0], lo[1], lo[2], lo[3], hh[0], hh[1], hh[2], hh[3]}; }
#pragma unroll
        for (int d0 = 0; d0 < 2; ++d0)
#pragma unroll
            for (int ks = 0; ks < 4; ++ks) o1[d0] = __builtin_amdgcn_mfma_f32_32x32x16_bf16(__builtin_bit_cast(bf16x8, pw[ks]), vf[d0][ks], o1[d0], 0, 0, 0);
        softmax_map(ta, tb, m2, l2, o2, pw, hi);
#pragma unroll
        for (int d0 = 0; d0 < 2; ++d0)
#pragma unroll
            for (int ks = 0; ks < 4; ++ks) o2[d0] = __builtin_amdgcn_mfma_f32_32x32x16_bf16(__builtin_bit_cast(bf16x8, pw[ks]), vf[d0][ks], o2[d0], 0, 0, 0);
        asm volatile("s_waitcnt vmcnt(0)" ::: "memory");
        __syncthreads();
    }
#undef ATT_GLDS
#undef ATT_DMA
    l1 = half_sum(l1); l2 = half_sum(l2);
    const float i1 = __builtin_amdgcn_rcpf(l1), i2 = lam * __builtin_amdgcn_rcpf(l2);
    int lane_ = lane; asm volatile("" : "+v"(lane_));
    const int r32e = lane_ & 31, hie = lane_ >> 5;
    const float g0 = F.in[18][l * 64 + r32e] * (1.f - lam_init), g1 = F.in[18][l * 64 + 32 + r32e] * (1.f - lam_init);
#pragma unroll
    for (int r = 0; r < 16; ++r) {
        const int qi = crow(r, hie);
        const float a = __int_as_float(__builtin_amdgcn_ds_bpermute(4 * qi, __float_as_int(i1))), b = __int_as_float(__builtin_amdgcn_ds_bpermute(4 * qi, __float_as_int(i2)));
        const float x0 = o1[0][r] * a - o2[0][r] * b, x1 = o1[1][r] * a - o2[1][r] * b;
        const float ss = sum32(x0 * x0 + x1 * x1);
        const float rs = __builtin_amdgcn_rsqf(ss * (1.f / 64.f) + EPS);
        bf16_t* yp = Y + (size_t)(q0 + wid * 32 + qi) * D + 512 + h * 64 + r32e;
        yp[0] = f2bf(x0 * rs * g0); yp[32] = f2bf(x1 * rs * g1);
    }
}
#ifndef ATT_VARIANT
#define ATT_VARIANT 0
#endif
#ifndef ATT_STAGGER
#define ATT_STAGGER 5
#endif
constexpr int SUBT = 4;
constexpr float THR2 = 40.f;
__device__ __forceinline__ void fast_map(f32x16& sa, f32x16& sb, float& l, u32x4 (&pw)[4]) {
    float sum = 0.f;
#pragma unroll
    for (int r = 0; r < 16; ++r) { sa[r] = __builtin_amdgcn_exp2f(sa[r]); sb[r] = __builtin_amdgcn_exp2f(sb[r]); sum += sa[r] + sb[r]; }
    l += sum;
    pw[0] = (u32x4){cvtpk(sa[0], sa[1]), cvtpk(sa[2], sa[3]), cvtpk(sa[4], sa[5]), cvtpk(sa[6], sa[7])};
    pw[1] = (u32x4){cvtpk(sa[8], sa[9]), cvtpk(sa[10], sa[11]), cvtpk(sa[12], sa[13]), cvtpk(sa[14], sa[15])};
    pw[2] = (u32x4){cvtpk(sb[0], sb[1]), cvtpk(sb[2], sb[3]), cvtpk(sb[4], sb[5]), cvtpk(sb[6], sb[7])};
    pw[3] = (u32x4){cvtpk(sb[8], sb[9]), cvtpk(sb[10], sb[11]), cvtpk(sb[12], sb[13]), cvtpk(sb[14], sb[15])};
}
template <bool FAST> __device__ __forceinline__ void attn_body2(Frame& F, int l, int h, int q0, int k0, int nt, float lam, float lam_init, int lane, const bf16x8 (&qr)[4]) {
    const bf16_t* Z = WSP(bf16_t, WS_Z); bf16_t* Y = WSP(bf16_t, WS_Y);
    const int r32 = lane & 31, hi = lane >> 5, wid = F.wave;
    const unsigned koff = (unsigned)(((k0 + 8 * wid + (lane & 7)) * ZLD + ZC_DK + h * 64 + ((lane >> 3) ^ ((wid >> 1) & 1)) * 8) * 2);
    const unsigned voff = (unsigned)(((k0 + 8 * wid + (lane >> 3)) * ZLD + ZC_DV + h * 64 + ((lane & 7) ^ (((lane >> 4) & 1) << 2)) * 8) * 2);
    LAS unsigned char* lds = F.lds;
    const unsigned lds0 = (unsigned)(size_t)lds;
#define ATT_GLDS2(voff_, sbase_, m0b_, imm_) do { unsigned keep_; asm volatile("s_mov_b32 %0, m0\n\ts_add_i32 m0, %3, %4\n\ts_nop 0\n\tglobal_load_lds_dwordx4 %1, %2\n\ts_mov_b32 m0, %0" \
        : "=&s"(keep_) : "v"(voff_), "s"(sbase_), "s"(m0b_), "n"(imm_) : "memory", "scc"); } while (0)
    const unsigned m0w = (unsigned)__builtin_amdgcn_readfirstlane(lds0 + wid * 1024);
#define ATT_DMA2(it_, slot) do { const unsigned m0s_ = m0w + (unsigned)(slot) * (SUBT * 16384); const char* zb_ = (const char*)Z + (size_t)(it_) * (SUBT * 64 * ZLD * 2); \
        _Pragma("unroll") for (int j_ = 0; j_ < SUBT; ++j_) { const char* zj_ = zb_ + (size_t)j_ * (64 * ZLD * 2); \
        ATT_GLDS2(koff, zj_, m0s_, j_ * 8192); ATT_GLDS2(voff, zj_, m0s_, SUBT * 8192 + j_ * 8192); } } while (0)
    __syncthreads();
    ATT_DMA2(0, 0);
    f32x16 o1[2], o2[2];
#pragma unroll
    for (int r = 0; r < 16; ++r) { o1[0][r] = 0.f; o1[1][r] = 0.f; o2[0][r] = 0.f; o2[1][r] = 0.f; }
    float m1 = FAST ? 0.f : -1e30f, m2 = m1, l1 = 0.f, l2 = 0.f;
    const int kfo = (r32 >> 3) * 1024 + (hi ^ (r32 >> 4)) * 128 + (r32 & 7) * 16;
    const int vkl = 4 * hi + ((lane & 15) >> 2), vfo = vkl * 128 + ((vkl >> 1) & 1) * 64 + ((lane >> 4) & 1) * 32 + (lane & 3) * 8;
    asm volatile("s_waitcnt vmcnt(0)" ::: "memory");
    __syncthreads();
    const int nit = nt / SUBT;
    for (int it = 0; it < nit; ++it) {
        const int cur = it & 1;
        if (it + 1 < nit) ATT_DMA2(it + 1, cur ^ 1);
#pragma unroll 1
        for (int j = 0; j < SUBT; ++j) {
            const LAS unsigned char* kp = lds + cur * (SUBT * 16384) + j * 8192 + kfo;
            const LAS unsigned char* vp = lds + cur * (SUBT * 16384) + SUBT * 8192 + j * 8192 + vfo;
            const f32x16 zero = {0.f, 0.f, 0.f, 0.f, 0.f, 0.f, 0.f, 0.f, 0.f, 0.f, 0.f, 0.f, 0.f, 0.f, 0.f, 0.f};
            u32x4 pw[4];
            bf16x8 kf[4];
#pragma unroll
            for (int d0 = 0; d0 < 2; ++d0) { kf[2 * d0] = *(const LAS bf16x8*)(kp + d0 * 256); kf[2 * d0 + 1] = *(const LAS bf16x8*)(kp + d0 * 256 + 4096); }
            f32x16 sa = __builtin_amdgcn_mfma_f32_32x32x16_bf16(kf[0], qr[0], zero, 0, 0, 0); sa = __builtin_amdgcn_mfma_f32_32x32x16_bf16(kf[2], qr[1], sa, 0, 0, 0);
            f32x16 sb = __builtin_amdgcn_mfma_f32_32x32x16_bf16(kf[1], qr[0], zero, 0, 0, 0); sb = __builtin_amdgcn_mfma_f32_32x32x16_bf16(kf[3], qr[1], sb, 0, 0, 0);
#pragma unroll
            for (int d0 = 0; d0 < 2; ++d0) { kf[2 * d0] = *(const LAS bf16x8*)(kp + 512 + d0 * 256); kf[2 * d0 + 1] = *(const LAS bf16x8*)(kp + 512 + d0 * 256 + 4096); }
            f32x16 ta = __builtin_amdgcn_mfma_f32_32x32x16_bf16(kf[0], qr[2], zero, 0, 0, 0); ta = __builtin_amdgcn_mfma_f32_32x32x16_bf16(kf[2], qr[3], ta, 0, 0, 0);
            f32x16 tb = __builtin_amdgcn_mfma_f32_32x32x16_bf16(kf[1], qr[2], zero, 0, 0, 0); tb = __builtin_amdgcn_mfma_f32_32x32x16_bf16(kf[3], qr[3], tb, 0, 0, 0);
            if constexpr (FAST) fast_map(sa, sb, l1, pw); else softmax_map(sa, sb, m1, l1, o1, pw, hi);
            bf16x8 vf[2][4];
#pragma unroll
            for (int d0 = 0; d0 < 2; ++d0)
#pragma unroll
                for (int ks = 0; ks < 4; ++ks) { const LAS unsigned char* vq = d0 ? (const LAS unsigned char*)((unsigned)(size_t)vp ^ 64u) : vp; const s16x4 lo = vtr(vq + ks * 2048), hh = vtr(vq + ks * 2048 + 1024);
                    vf[d0][ks] = (bf16x8){lo[0], lo[1], lo[2], lo[3], hh[0], hh[1], hh[2], hh[3]}; }
#pragma unroll
            for (int d0 = 0; d0 < 2; ++d0)
#pragma unroll
                for (int ks = 0; ks < 4; ++ks) o1[d0] = __builtin_amdgcn_mfma_f32_32x32x16_bf16(__builtin_bit_cast(bf16x8, pw[ks]), vf[d0][ks], o1[d0], 0, 0, 0);
            if constexpr (FAST) fast_map(ta, tb, l2, pw); else softmax_map(ta, tb, m2, l2, o2, pw, hi);
#pragma unroll
            for (int d0 = 0; d0 < 2; ++d0)
#pragma unroll
                for (int ks = 0; ks < 4; ++ks) o2[d0] = __builtin_amdgcn_mfma_f32_32x32x16_bf16(__builtin_bit_cast(bf16x8, pw[ks]), vf[d0][ks], o2[d0], 0, 0, 0);
        }
        asm volatile("s_waitcnt vmcnt(0)" ::: "memory");
        __syncthreads();
    }
#undef ATT_GLDS2
#undef ATT_DMA2
    l1 = half_sum(l1); l2 = half_sum(l2);
    { int lz_ = __builtin_amdgcn_readfirstlane(l); asm volatile("" : "+s"(lz_)); lam_init = (lz_ == 0) ? 0.2f : (0.8f - 0.6f * 0.7408182206817179f); lam = diff_lambda(F, lz_, lam_init); }
    const float i1 = __builtin_amdgcn_rcpf(l1), i2 = lam * __builtin_amdgcn_rcpf(l2);
    int lane_; asm volatile("v_mbcnt_lo_u32_b32 %0, -1, 0\n\tv_mbcnt_hi_u32_b32 %0, -1, %0" : "=v"(lane_));
    const int r32e = lane_ & 31, hie = lane_ >> 5;
    const float g0 = F.in[18][l * 64 + r32e] * (1.f - lam_init), g1 = F.in[18][l * 64 + 32 + r32e] * (1.f - lam_init);
    LAS unsigned char* ost = F.lds + 65536 + F.wave * 4096;
#pragma unroll
    for (int r = 0; r < 16; ++r) {
        const int qi = crow(r, hie);
        const float a = __int_as_float(__builtin_amdgcn_ds_bpermute(4 * qi, __float_as_int(i1))), b = __int_as_float(__builtin_amdgcn_ds_bpermute(4 * qi, __float_as_int(i2)));
        const float x0 = o1[0][r] * a - o2[0][r] * b, x1 = o1[1][r] * a - o2[1][r] * b;
        const float ss = sum32(x0 * x0 + x1 * x1);
        const float rs = __builtin_amdgcn_rsqf(ss * (1.f / 64.f) + EPS);
        tile_put(ost, qi, r32e, x0 * rs * g0); tile_put(ost, qi, 32 + r32e, x1 * rs * g1);
    }
    tile_flush(ost, Y + (size_t)(q0 + wid * 32) * D + 512 + h * 64, D, lane_);
}
template <int VAR> __device__ __forceinline__ void attn_body3(Frame& F, int l, int h, int q0, int k0, int nt, float lam, float lam_init, int lane, const bf16x8 (&qr)[4], bf16_t* Y) {
    const bf16_t* Z = WSP(bf16_t, WS_Z);
    const int r32 = lane & 31, hi = lane >> 5, wid = F.wave;
#define KOFF(ln_) ((unsigned)(((k0 + 8 * wid + ((ln_) & 7)) * ZLD + ZC_DK + h * 64 + (((ln_) >> 3) ^ ((wid >> 1) & 1)) * 8) * 2))
#define VOFF(ln_) ((unsigned)(((k0 + 8 * wid + ((ln_) >> 3)) * ZLD + ZC_DV + h * 64 + (((ln_) & 7) ^ ((((ln_) >> 4) & 1) << 2)) * 8) * 2))
    LAS unsigned char* lds = F.lds;
    const unsigned lds0 = (unsigned)(size_t)lds;
#define ATT_GLDS2(voff_, sbase_, m0b_, imm_) do { unsigned keep_; asm volatile("s_mov_b32 %0, m0\n\ts_add_i32 m0, %3, %4\n\ts_nop 0\n\tglobal_load_lds_dwordx4 %1, %2\n\ts_mov_b32 m0, %0" \
        : "=&s"(keep_) : "v"(voff_), "s"(sbase_), "s"(m0b_), "n"(imm_) : "memory", "scc"); } while (0)
    const unsigned m0w = (unsigned)__builtin_amdgcn_readfirstlane(lds0 + wid * 1024);
#define ATT_DMA2(it_, slot) do { int ln_ = lane; asm volatile("" : "+v"(ln_)); const unsigned koff = KOFF(ln_), voff = VOFF(ln_); const unsigned m0s_ = m0w + (unsigned)(slot) * (SUBT * 16384); const char* zb_ = (const char*)Z + (size_t)(it_) * (SUBT * 64 * ZLD * 2); \
        _Pragma("unroll") for (int j_ = 0; j_ < SUBT; ++j_) { const char* zj_ = zb_ + (size_t)j_ * (64 * ZLD * 2); \
        ATT_GLDS2(koff, zj_, m0s_, j_ * 8192); ATT_GLDS2(voff, zj_, m0s_, SUBT * 8192 + j_ * 8192); } } while (0)
    __syncthreads();
    ATT_DMA2(0, 0);
    f32x16 o1[2], o2[2], pA0, pA1, pB0, pB1;
#pragma unroll
    for (int r = 0; r < 16; ++r) { o1[0][r] = 0.f; o1[1][r] = 0.f; o2[0][r] = 0.f; o2[1][r] = 0.f; pB0[r] = 0.f; pB1[r] = 0.f; }
    float l1 = 0.f, l2 = 0.f;
    bf16x8 vf[2][4];
#pragma unroll
    for (int d0 = 0; d0 < 2; ++d0)
#pragma unroll
        for (int ks = 0; ks < 4; ++ks) vf[d0][ks] = (bf16x8){0, 0, 0, 0, 0, 0, 0, 0};
    asm volatile("s_waitcnt vmcnt(0)" ::: "memory");
    __syncthreads();
    const int nit = nt / SUBT;
    const f32x16 zero = {0.f, 0.f, 0.f, 0.f, 0.f, 0.f, 0.f, 0.f, 0.f, 0.f, 0.f, 0.f, 0.f, 0.f, 0.f, 0.f};
    bf16x8 kf[4];
#define SBAR() __builtin_amdgcn_sched_barrier(0)
#define FADD(acc_, x_) asm("v_add_f32_e32 %0, %1, %0" : "+v"(acc_) : "v"(x_))
#define EX(v) ((VAR == 1) ? (v) : __builtin_amdgcn_exp2f(v))
#define PVM(acc_, a_, b_) ((VAR == 2) ? (acc_) : __builtin_amdgcn_mfma_f32_32x32x16_bf16(a_, b_, acc_, 0, 0, 0))
#define KLOAD(kp_) do { kf[0] = *(const LAS bf16x8*)(kp_); kf[1] = *(const LAS bf16x8*)((kp_) + 4096); kf[2] = *(const LAS bf16x8*)((kp_) + 256); kf[3] = *(const LAS bf16x8*)((kp_) + 4352); } while (0)
#define VRD(d0_, ks_) do { if (VAR == 4) break; const LAS unsigned char* vq_ = (d0_) ? (const LAS unsigned char*)((unsigned)(size_t)vp_ ^ 64u) : vp_; const s16x4 lo_ = vtr(vq_ + (ks_) * 2048), hh_ = vtr(vq_ + (ks_) * 2048 + 1024); \
        vf[d0_][ks_] = (bf16x8){lo_[0], lo_[1], lo_[2], lo_[3], hh_[0], hh_[1], hh_[2], hh_[3]}; } while (0)
#define ADD8I(s0_, s1_, s2_, s3_, a0_, a1_, a2_, a3_, b0_, b1_, b2_, b3_, c0_, c1_, c2_, c3_) asm("v_add_f32_e32 %0, %4, %8\n\tv_add_f32_e32 %1, %5, %9\n\tv_add_f32_e32 %2, %6, %10\n\tv_add_f32_e32 %3, %7, %11\n\t" \
        "v_add_f32_e32 %0, %12, %0\n\tv_add_f32_e32 %1, %13, %1\n\tv_add_f32_e32 %2, %14, %2\n\tv_add_f32_e32 %3, %15, %3" : "=&v"(s0_), "=&v"(s1_), "=&v"(s2_), "=&v"(s3_) \
        : "v"(a0_), "v"(a1_), "v"(a2_), "v"(a3_), "v"(b0_), "v"(b1_), "v"(b2_), "v"(b3_), "v"(c0_), "v"(c1_), "v"(c2_), "v"(c3_))
#define ADD8(s0_, s1_, s2_, s3_, a0_, a1_, a2_, a3_, b0_, b1_, b2_, b3_) asm("v_add_f32_e32 %0, %4, %0\n\tv_add_f32_e32 %1, %5, %1\n\tv_add_f32_e32 %2, %6, %2\n\tv_add_f32_e32 %3, %7, %3\n\t" \
        "v_add_f32_e32 %0, %8, %0\n\tv_add_f32_e32 %1, %9, %1\n\tv_add_f32_e32 %2, %10, %2\n\tv_add_f32_e32 %3, %11, %3" : "+v"(s0_), "+v"(s1_), "+v"(s2_), "+v"(s3_) \
        : "v"(a0_), "v"(a1_), "v"(a2_), "v"(a3_), "v"(b0_), "v"(b1_), "v"(b2_), "v"(b3_))
#define ADD8F(s0_, s1_, s2_, s3_, a0_, a1_, a2_, a3_, lp_) asm("v_add_f32_e32 %0, %5, %0\n\tv_add_f32_e32 %1, %6, %1\n\tv_add_f32_e32 %2, %7, %2\n\tv_add_f32_e32 %3, %8, %3\n\t" \
        "v_add_f32_e32 %0, %1, %0\n\tv_add_f32_e32 %2, %3, %2\n\tv_add_f32_e32 %0, %2, %0\n\tv_add_f32_e32 %4, %0, %4" : "+v"(s0_), "+v"(s1_), "+v"(s2_), "+v"(s3_), "+v"(lp_) \
        : "v"(a0_), "v"(a1_), "v"(a2_), "v"(a3_))
#define STEP(C0, C1, P0, P1, QA, QB, OP, LP, VL, KNP, KN) do { \
        float s0_, s1_, s2_, s3_; u32x4 pwa_, pwb_; \
        C0 = __builtin_amdgcn_mfma_f32_32x32x16_bf16(kf[0], QA, zero, 0, 0, 0); SBAR(); \
        ADD8I(s0_, s1_, s2_, s3_, P0[0], P0[1], P0[2], P0[3], P0[4], P0[5], P0[6], P0[7], P0[8], P0[9], P0[10], P0[11]); \
        if (VL) { VRD(0, 0); VRD(1, 0); VRD(0, 1); VRD(1, 1); } SBAR(); \
        C0 = __builtin_amdgcn_mfma_f32_32x32x16_bf16(kf[2], QB, C0, 0, 0, 0); SBAR(); \
        ADD8(s0_, s1_, s2_, s3_, P0[12], P0[13], P0[14], P0[15], P1[0], P1[1], P1[2], P1[3]); \
        if (VL) { VRD(0, 2); VRD(1, 2); VRD(0, 3); VRD(1, 3); } SBAR(); \
        C1 = __builtin_amdgcn_mfma_f32_32x32x16_bf16(kf[1], QA, zero, 0, 0, 0); SBAR(); \
        ADD8(s0_, s1_, s2_, s3_, P1[4], P1[5], P1[6], P1[7], P1[8], P1[9], P1[10], P1[11]); \
        SBAR(); \
        C1 = __builtin_amdgcn_mfma_f32_32x32x16_bf16(kf[3], QB, C1, 0, 0, 0); SBAR(); \
        pwa_ = (u32x4){cvtpk(P0[0], P0[1]), cvtpk(P0[2], P0[3]), cvtpk(P0[4], P0[5]), cvtpk(P0[6], P0[7])}; SBAR(); \
        ADD8F(s0_, s1_, s2_, s3_, P1[12], P1[13], P1[14], P1[15], LP); SBAR(); \
        pwb_.x = cvtpk(P0[8], P0[9]); pwb_.y = cvtpk(P0[10], P0[11]); SBAR(); \
        OP[0] = PVM(OP[0], __builtin_bit_cast(bf16x8, pwa_), vf[0][0]); C0[0] = EX(C0[0]); C0[1] = EX(C0[1]); C0[2] = EX(C0[2]); C0[3] = EX(C0[3]); \
        if (KN) KLOAD(KNP); SBAR(); \
        OP[1] = PVM(OP[1], __builtin_bit_cast(bf16x8, pwa_), vf[1][0]); pwb_.z = cvtpk(P0[12], P0[13]); pwb_.w = cvtpk(P0[14], P0[15]); SBAR(); C0[4] = EX(C0[4]); C0[5] = EX(C0[5]); C0[6] = EX(C0[6]); C0[7] = EX(C0[7]); \
        SBAR(); \
        OP[0] = PVM(OP[0], __builtin_bit_cast(bf16x8, pwb_), vf[0][1]); pwa_.x = cvtpk(P1[0], P1[1]); pwa_.y = cvtpk(P1[2], P1[3]); SBAR(); C0[8] = EX(C0[8]); C0[9] = EX(C0[9]); C0[10] = EX(C0[10]); C0[11] = EX(C0[11]); \
        SBAR(); \
        OP[1] = PVM(OP[1], __builtin_bit_cast(bf16x8, pwb_), vf[1][1]); pwa_.z = cvtpk(P1[4], P1[5]); pwa_.w = cvtpk(P1[6], P1[7]); SBAR(); C0[12] = EX(C0[12]); C0[13] = EX(C0[13]); C0[14] = EX(C0[14]); C0[15] = EX(C0[15]); \
        SBAR(); \
        OP[0] = PVM(OP[0], __builtin_bit_cast(bf16x8, pwa_), vf[0][2]); pwb_.x = cvtpk(P1[8], P1[9]); pwb_.y = cvtpk(P1[10], P1[11]); SBAR(); C1[0] = EX(C1[0]); C1[1] = EX(C1[1]); C1[2] = EX(C1[2]); C1[3] = EX(C1[3]); \
        SBAR(); \
        OP[1] = PVM(OP[1], __builtin_bit_cast(bf16x8, pwa_), vf[1][2]); pwb_.z = cvtpk(P1[12], P1[13]); pwb_.w = cvtpk(P1[14], P1[15]); SBAR(); C1[4] = EX(C1[4]); C1[5] = EX(C1[5]); C1[6] = EX(C1[6]); C1[7] = EX(C1[7]); \
        SBAR(); \
        OP[0] = PVM(OP[0], __builtin_bit_cast(bf16x8, pwb_), vf[0][3]); C1[8] = EX(C1[8]); C1[9] = EX(C1[9]); C1[10] = EX(C1[10]); C1[11] = EX(C1[11]); SBAR(); \
        OP[1] = PVM(OP[1], __builtin_bit_cast(bf16x8, pwb_), vf[1][3]); C1[12] = EX(C1[12]); C1[13] = EX(C1[13]); C1[14] = EX(C1[14]); C1[15] = EX(C1[15]); SBAR(); \
    } while (0)
    if (wid >= 4) __builtin_amdgcn_s_setprio(1);
    for (int it = 0; it < nit; ++it) {
        const int cur = it & 1;
        int ln2_; asm volatile("v_mbcnt_lo_u32_b32 %0, -1, 0\n\tv_mbcnt_hi_u32_b32 %0, -1, %0" : "=v"(ln2_));
        const int kfo = ((ln2_ & 31) >> 3) * 1024 + ((ln2_ >> 5) ^ ((ln2_ >> 4) & 1)) * 128 + (ln2_ & 7) * 16;
        const int vkl_ = 4 * (ln2_ >> 5) + ((ln2_ & 15) >> 2), vfo = vkl_ * 128 + ((vkl_ >> 1) & 1) * 64 + ((ln2_ >> 4) & 1) * 32 + (ln2_ & 3) * 8;
        const LAS unsigned char* kb = lds + cur * (SUBT * 16384) + kfo;
        const LAS unsigned char* vb = lds + cur * (SUBT * 16384) + SUBT * 8192 + vfo;
        KLOAD(kb);
        SBAR();
        if (it + 1 < nit) ATT_DMA2(it + 1, cur ^ 1);
#pragma unroll
        for (int j = 0; j < SUBT; ++j) {
            const LAS unsigned char* kp = kb + j * 8192;
            const LAS unsigned char* vp_ = vb + j * 8192;
            STEP(pA0, pA1, pB0, pB1, qr[0], qr[1], o2, l2, false, kp + 512, true);
            STEP(pB0, pB1, pA0, pA1, qr[2], qr[3], o1, l1, true, kp + 8192, (j + 1 < SUBT));
        }
        asm volatile("s_waitcnt vmcnt(0)" ::: "memory");
        __syncthreads();
    }
    __builtin_amdgcn_s_setprio(0);
    {
        float sacc_ = 0.f;
#pragma unroll
        for (int r = 0; r < 16; ++r) sacc_ += pB0[r] + pB1[r];
        l2 += sacc_;
        u32x4 pw0, pw1, pw2, pw3;
        pw0 = (u32x4){cvtpk(pB0[0], pB0[1]), cvtpk(pB0[2], pB0[3]), cvtpk(pB0[4], pB0[5]), cvtpk(pB0[6], pB0[7])};
        pw1 = (u32x4){cvtpk(pB0[8], pB0[9]), cvtpk(pB0[10], pB0[11]), cvtpk(pB0[12], pB0[13]), cvtpk(pB0[14], pB0[15])};
        pw2 = (u32x4){cvtpk(pB1[0], pB1[1]), cvtpk(pB1[2], pB1[3]), cvtpk(pB1[4], pB1[5]), cvtpk(pB1[6], pB1[7])};
        pw3 = (u32x4){cvtpk(pB1[8], pB1[9]), cvtpk(pB1[10], pB1[11]), cvtpk(pB1[12], pB1[13]), cvtpk(pB1[14], pB1[15])};
#pragma unroll
        for (int d0 = 0; d0 < 2; ++d0) {
            o2[d0] = __builtin_amdgcn_mfma_f32_32x32x16_bf16(__builtin_bit_cast(bf16x8, pw0), vf[d0][0], o2[d0], 0, 0, 0);
            o2[d0] = __builtin_amdgcn_mfma_f32_32x32x16_bf16(__builtin_bit_cast(bf16x8, pw1), vf[d0][1], o2[d0], 0, 0, 0);
            o2[d0] = __builtin_amdgcn_mfma_f32_32x32x16_bf16(__builtin_bit_cast(bf16x8, pw2), vf[d0][2], o2[d0], 0, 0, 0);
            o2[d0] = __builtin_amdgcn_mfma_f32_32x32x16_bf16(__builtin_bit_cast(bf16x8, pw3), vf[d0][3], o2[d0], 0, 0, 0);
        }
    }
#undef STEP
#undef VRD
#undef KLOAD
#undef EX
#undef PVM
#undef FADD
#undef ADD8I
#undef ADD8
#undef ADD8F
#undef SBAR
#undef ATT_GLDS2
#undef ATT_DMA2
#undef KOFF
#undef VOFF
    l1 = half_sum(l1); l2 = half_sum(l2);
    { int lz_ = __builtin_amdgcn_readfirstlane(l); asm volatile("" : "+s"(lz_)); lam_init = (lz_ == 0) ? 0.2f : (0.8f - 0.6f * 0.7408182206817179f); lam = diff_lambda(F, lz_, lam_init); }
    const float i1 = __builtin_amdgcn_rcpf(l1), i2 = lam * __builtin_amdgcn_rcpf(l2);
    int lane_; asm volatile("v_mbcnt_lo_u32_b32 %0, -1, 0\n\tv_mbcnt_hi_u32_b32 %0, -1, %0" : "=v"(lane_));
    const int r32e = lane_ & 31, hie = lane_ >> 5;
    const float g0 = F.in[18][l * 64 + r32e] * (1.f - lam_init), g1 = F.in[18][l * 64 + 32 + r32e] * (1.f - lam_init);
    LAS unsigned char* ost = F.lds + 65536 + F.wave * 4096;
#pragma unroll
    for (int r = 0; r < 16; ++r) {
        const int qi = crow(r, hie);
        const float a = __int_as_float(__builtin_amdgcn_ds_bpermute(4 * qi, __float_as_int(i1))), b = __int_as_float(__builtin_amdgcn_ds_bpermute(4 * qi, __float_as_int(i2)));
        const float x0 = o1[0][r] * a - o2[0][r] * b, x1 = o1[1][r] * a - o2[1][r] * b;
        const float ss = sum32(x0 * x0 + x1 * x1);
        const float rs = __builtin_amdgcn_rsqf(ss * (1.f / 64.f) + EPS);
        tile_put(ost, qi, r32e, x0 * rs * g0); tile_put(ost, qi, 32 + r32e, x1 * rs * g1);
    }
    tile_flush(ost, Y + (size_t)(q0 + wid * 32) * D + 512 + h * 64, D, lane_);
}
__device__ __forceinline__ void attn_unit2(Frame& F, int l, int h, int q0, int k0, int nt, float lam, float lam_init, bool isdup) {
    const bf16_t* Z = WSP(bf16_t, WS_Z);
    int lane; asm volatile("v_mbcnt_lo_u32_b32 %0, -1, 0\n\tv_mbcnt_hi_u32_b32 %0, -1, %0" : "=v"(lane));
    const int r32 = lane & 31, hi = lane >> 5;
    const bf16_t* Qw = Z + (size_t)(q0 + F.wave * 32) * ZLD + ZC_DQ + h * 64;
    bf16x8 qr[4];
#pragma unroll
    for (int d0 = 0; d0 < 4; ++d0) qr[d0] = *(const bf16x8*)(Qw + (size_t)r32 * ZLD + d0 * 16 + hi * 8);
    float q21 = 0.f, q22 = 0.f;
#pragma unroll
    for (int j = 0; j < 8; ++j) { const float a = bf2f((bf16_t)qr[0][j]), b = bf2f((bf16_t)qr[1][j]), c = bf2f((bf16_t)qr[2][j]), d = bf2f((bf16_t)qr[3][j]); q21 += a * a + b * b; q22 += c * c + d * d; }
    const float* kg = (const float*)(WSP(unsigned, WS_CTL) + CW_KMAXG + l * 8 + h * 2);
    const float k1 = kg[0], k2 = kg[1];
    const bool safe = (2.f * q21 * k1 <= THR2 * THR2) && (2.f * q22 * k2 <= THR2 * THR2);
#if DUP_KIND == 4
    if (__all(safe)) { if (isdup) attn_body3<ATT_VARIANT>(F, l, h, q0, k0, nt, lam, lam_init, lane, qr, WSP(bf16_t, WS_H)); else attn_body2<true>(F, l, h, q0, k0, nt, lam, lam_init, lane, qr); }
#else
    if (__all(safe)) attn_body3<0>(F, l, h, q0, k0, nt, lam, lam_init, lane, qr, WSP(bf16_t, WS_Y));
#endif
    else attn_body2<false>(F, l, h, q0, k0, nt, lam, lam_init, lane, qr);
}
__device__ __forceinline__ void ret_unit(Frame& F, int l, int n, int hp) {
    const bf16_t* Z = WSP(bf16_t, WS_Z); bf16_t* Y = WSP(bf16_t, WS_Y); const bf16_t* SS = WSP(bf16_t, WS_SST);
    int lane; asm volatile("v_mbcnt_lo_u32_b32 %0, -1, 0\n\tv_mbcnt_hi_u32_b32 %0, -1, %0" : "=v"(lane));
    int wid = F.wave; asm volatile("" : "+s"(wid));
    const int r32 = lane & 31, hi = lane >> 5, hs = wid >> 2, wq = wid & 3, h = 2 * hp + hs;
    LAS unsigned char* lds = F.lds + hs * 24576;
    const unsigned lds0 = (unsigned)(size_t)lds;
#define RET_GLDS2(voff_, sbase_, m0b_, imm_) do { unsigned keep_; asm volatile("s_mov_b32 %0, m0\n\ts_add_i32 m0, %3, %4\n\ts_nop 0\n\tglobal_load_lds_dwordx4 %1, %2\n\ts_mov_b32 m0, %0" \
        : "=&s"(keep_) : "v"(voff_), "s"(sbase_), "s"(m0b_), "n"(imm_) : "memory", "scc"); } while (0)
    __syncthreads();
    const size_t t0 = (size_t)n * 128;
    {
        const char* zb = (const char*)(Z + t0 * ZLD);
        const unsigned m0k = (unsigned)__builtin_amdgcn_readfirstlane(lds0 + wq * 2048), m0v = (unsigned)__builtin_amdgcn_readfirstlane(lds0 + 8192 + wq * 2048);
        const unsigned kof = (unsigned)((lane * ZLD + ZC_RK + h * 32 + wq * 8) * 2);
        const unsigned vof = (unsigned)(((wq * 32 + (lane >> 2)) * ZLD + ZC_RV + h * 64 + (lane & 3) * 8) * 2);
        RET_GLDS2(kof, zb, m0k, 0); RET_GLDS2(kof, zb + (size_t)64 * ZLD * 2, m0k, 1024);
        RET_GLDS2(vof, zb, m0v, 0); RET_GLDS2(vof, zb + (size_t)16 * ZLD * 2, m0v, 1024);
        RET_GLDS2(vof, zb + 64, m0v, 8192); RET_GLDS2(vof, zb + (size_t)16 * ZLD * 2 + 64, m0v, 8192 + 1024);
    }
    const float lf = F.in[19][l * 4 + h] * 1.4426950408889634f, lb = F.in[20][l * 4 + h] * 1.4426950408889634f;
    const int qi = wq * 32 + r32;
    u32x4 qf[2];
#pragma unroll
    for (int s_ = 0; s_ < 2; ++s_) qf[s_] = *(const u32x4*)(Z + (t0 + qi) * ZLD + ZC_RQ + h * 32 + s_ * 16 + hi * 8);
    const float dqf = __builtin_amdgcn_exp2f((float)(qi + 1) * lf), dqb = __builtin_amdgcn_exp2f((float)(128 - qi) * lb);
    f32x16 o[2];
#pragma unroll
    for (int r = 0; r < 16; ++r) { o[0][r] = 0.f; o[1][r] = 0.f; }
    {
        const bf16_t* sf = SS + (((size_t)0 * NCH + n) * 4 + h) * 2048; const bf16_t* sb = SS + (((size_t)1 * NCH + n) * 4 + h) * 2048;
#pragma unroll
        for (int s_ = 0; s_ < 2; ++s_) {
            const u32x4 q = qf[s_];
            u32x4 qa, qb;
            qa.x = cvtpk(bflo(q.x) * dqf, bfhi(q.x) * dqf); qa.y = cvtpk(bflo(q.y) * dqf, bfhi(q.y) * dqf); qa.z = cvtpk(bflo(q.z) * dqf, bfhi(q.z) * dqf); qa.w = cvtpk(bflo(q.w) * dqf, bfhi(q.w) * dqf);
            qb.x = cvtpk(bflo(q.x) * dqb, bfhi(q.x) * dqb); qb.y = cvtpk(bflo(q.y) * dqb, bfhi(q.y) * dqb); qb.z = cvtpk(bflo(q.z) * dqb, bfhi(q.z) * dqb); qb.w = cvtpk(bflo(q.w) * dqb, bfhi(q.w) * dqb);
#pragma unroll
            for (int dh = 0; dh < 2; ++dh) {
                const bf16x8 bf_ = *(const bf16x8*)(sf + (dh * 32 + r32) * 32 + s_ * 16 + hi * 8), bb_ = *(const bf16x8*)(sb + (dh * 32 + r32) * 32 + s_ * 16 + hi * 8);
                o[dh] = __builtin_amdgcn_mfma_f32_32x32x16_bf16(__builtin_bit_cast(bf16x8, qa), bf_, o[dh], 0, 0, 0);
                o[dh] = __builtin_amdgcn_mfma_f32_32x32x16_bf16(__builtin_bit_cast(bf16x8, qb), bb_, o[dh], 0, 0, 0);
            }
        }
    }
    asm volatile("s_waitcnt vmcnt(0)" ::: "memory");
    __syncthreads();
    const LAS unsigned char* kp = lds + hi * 2048 + r32 * 16;
    const LAS unsigned char* vp = lds + 8192 + ((lane >> 4) & 1) * 32 + (lane & 3) * 8 + (4 * hi + ((lane & 15) >> 2)) * 64;
    const f32x16 zero = {0.f, 0.f, 0.f, 0.f, 0.f, 0.f, 0.f, 0.f, 0.f, 0.f, 0.f, 0.f, 0.f, 0.f, 0.f, 0.f};
#pragma unroll
    for (int kb = 0; kb < 4; ++kb) {
        const bf16x8 k0_ = *(const LAS bf16x8*)(kp + 0 * 2048 + kb * 512), k1_ = *(const LAS bf16x8*)(kp + 2 * 2048 + kb * 512);
        f32x16 sc = __builtin_amdgcn_mfma_f32_32x32x16_bf16(k0_, __builtin_bit_cast(bf16x8, qf[0]), zero, 0, 0, 0);
        sc = __builtin_amdgcn_mfma_f32_32x32x16_bf16(k1_, __builtin_bit_cast(bf16x8, qf[1]), sc, 0, 0, 0);
#pragma unroll
        for (int r = 0; r < 16; ++r) { const int dd = qi - (kb * 32 + crow(r, hi));
            const float fac = (dd > 0) ? __builtin_amdgcn_exp2f((float)dd * lf) : (dd < 0) ? __builtin_amdgcn_exp2f((float)(-dd) * lb) : 2.f;
            sc[r] *= fac; }
        u32x4 pw[2];
        pw[0] = (u32x4){cvtpk(sc[0], sc[1]), cvtpk(sc[2], sc[3]), cvtpk(sc[4], sc[5]), cvtpk(sc[6], sc[7])};
        pw[1] = (u32x4){cvtpk(sc[8], sc[9]), cvtpk(sc[10], sc[11]), cvtpk(sc[12], sc[13]), cvtpk(sc[14], sc[15])};
#pragma unroll
        for (int s_ = 0; s_ < 2; ++s_) { const int ks = 2 * kb + s_;
#pragma unroll
            for (int dh = 0; dh < 2; ++dh) { const s16x4 lo = vtr(vp + dh * 8192 + ks * 1024), hh = vtr(vp + dh * 8192 + ks * 1024 + 512);
                const bf16x8 vf = (bf16x8){lo[0], lo[1], lo[2], lo[3], hh[0], hh[1], hh[2], hh[3]};
                o[dh] = __builtin_amdgcn_mfma_f32_32x32x16_bf16(__builtin_bit_cast(bf16x8, pw[s_]), vf, o[dh], 0, 0, 0); } }
    }
#undef RET_GLDS2
    int lane_ = lane; asm volatile("" : "+v"(lane_));
    const int r32e = lane_ & 31, hie = lane_ >> 5;
    LAS unsigned char* ost = F.lds + 65536 + wid * 4096;
    bf16_t gq[16][2];
#pragma unroll
    for (int r = 0; r < 16; ++r) { const bf16_t* gp = Z + (t0 + wq * 32 + crow(r, hie)) * ZLD + ZC_RG + h * 64 + r32e; gq[r][0] = gp[0]; gq[r][1] = gp[32]; }
#pragma unroll
    for (int r = 0; r < 16; ++r) {
        const size_t tok = t0 + wq * 32 + crow(r, hie);
        const float mean = sum32(o[0][r] + o[1][r]) * (1.f / 64.f);
        const float d0_ = o[0][r] - mean, d1_ = o[1][r] - mean;
        const float rstd = __builtin_amdgcn_rsqf(sum32(d0_ * d0_ + d1_ * d1_) * (1.f / 64.f) + EPS);
        tile_put(ost, crow(r, hie), r32e, siluf_(bf2f(gq[r][0])) * d0_ * rstd); tile_put(ost, crow(r, hie), 32 + r32e, siluf_(bf2f(gq[r][1])) * d1_ * rstd);
    }
    tile_flush(ost, Y + (t0 + wq * 32) * D + 768 + h * 64, D, lane_);
}
}

__device__ __forceinline__ float diff_lambda(Frame& F, int l, float lam_init) {
    float a = 0.f, b = 0.f;
    for (int i = 0; i < 32; ++i) { a += F.in[14][l * 32 + i] * F.in[15][l * 32 + i]; b += F.in[16][l * 32 + i] * F.in[17][l * 32 + i]; }
    return expf(a) - expf(b) + lam_init;
}
__device__ __forceinline__ void naive_attn_item(Frame& F, int l, int item, float lam, float lam_init) {
    const bf16_t* Z = WSP(bf16_t, WS_Z); bf16_t* Y = WSP(bf16_t, WS_Y);
    int h, q, k0, k1; const int mp = F.tid & 1;
    if (item < 256) { h = item & 3; q = (item >> 2) * 256 + (F.tid >> 1); k0 = 0; k1 = MT; }
    else { h = item - 256; q = SEQ + (F.tid >> 1); k0 = SEQ; k1 = MT; }
    float qv[32], o[64];
#pragma unroll
    for (int i = 0; i < 4; ++i) { const u32x4 a = *(const u32x4*)(Z + (size_t)q * ZLD + ZC_DQ + h * 64 + mp * 32 + i * 8);
        qv[i * 8 + 0] = bflo(a.x); qv[i * 8 + 1] = bfhi(a.x); qv[i * 8 + 2] = bflo(a.y); qv[i * 8 + 3] = bfhi(a.y); qv[i * 8 + 4] = bflo(a.z); qv[i * 8 + 5] = bfhi(a.z); qv[i * 8 + 6] = bflo(a.w); qv[i * 8 + 7] = bfhi(a.w); }
#pragma unroll
    for (int e = 0; e < 64; ++e) o[e] = 0.f;
    float m1 = -1e30f, l1 = 0.f;
    for (int j = k0; j < k1; ++j) {
        const bf16_t* kr = Z + (size_t)j * ZLD + ZC_DK + h * 64 + mp * 32; const bf16_t* vr = Z + (size_t)j * ZLD + ZC_DV + h * 64;
        float s1 = 0.f;
#pragma unroll
        for (int i = 0; i < 4; ++i) { const u32x4 a = *(const u32x4*)(kr + i * 8);
            s1 += qv[i * 8 + 0] * bflo(a.x) + qv[i * 8 + 1] * bfhi(a.x) + qv[i * 8 + 2] * bflo(a.y) + qv[i * 8 + 3] * bfhi(a.y) + qv[i * 8 + 4] * bflo(a.z) + qv[i * 8 + 5] * bfhi(a.z) + qv[i * 8 + 6] * bflo(a.w) + qv[i * 8 + 7] * bfhi(a.w); }
        if (s1 > m1) { const float f = __builtin_amdgcn_exp2f(m1 - s1); l1 *= f;
#pragma unroll
            for (int e = 0; e < 64; ++e) o[e] *= f;
            m1 = s1; }
        const float p1 = __builtin_amdgcn_exp2f(s1 - m1); l1 += p1;
#pragma unroll
        for (int i = 0; i < 8; ++i) { const u32x4 a = *(const u32x4*)(vr + i * 8);
            o[i * 8 + 0] += p1 * bflo(a.x); o[i * 8 + 1] += p1 * bfhi(a.x); o[i * 8 + 2] += p1 * bflo(a.y); o[i * 8 + 3] += p1 * bfhi(a.y); o[i * 8 + 4] += p1 * bflo(a.z); o[i * 8 + 5] += p1 * bfhi(a.z); o[i * 8 + 6] += p1 * bflo(a.w); o[i * 8 + 7] += p1 * bfhi(a.w); }
        asm volatile("" ::: "memory");
    }
    const float sc = mp ? (-lam / l1) : (1.f / l1); float ss = 0.f;
#pragma unroll
    for (int e = 0; e < 64; ++e) { o[e] *= sc; o[e] += xor1_f(o[e]); ss += o[e] * o[e]; }
    const float rs = __builtin_amdgcn_rsqf(ss * (1.f / 64.f) + EPS) * (1.f - lam_init);
#pragma unroll
    for (int i = 0; i < 8; ++i) { const float* g = F.in[18] + l * 64 + i * 8;
        u32x4 w; w.x = cvtpk(o[i * 8 + 0] * rs * g[0], o[i * 8 + 1] * rs * g[1]); w.y = cvtpk(o[i * 8 + 2] * rs * g[2], o[i * 8 + 3] * rs * g[3]);
        w.z = cvtpk(o[i * 8 + 4] * rs * g[4], o[i * 8 + 5] * rs * g[5]); w.w = cvtpk(o[i * 8 + 6] * rs * g[6], o[i * 8 + 7] * rs * g[7]);
        if ((i >> 2) == mp) *(u32x4*)(Y + (size_t)q * D + 512 + h * 64 + i * 8) = w; }
}
__device__ __forceinline__ void naive_ret_item(Frame& F, int l, int n) {
    const bf16_t* Z = WSP(bf16_t, WS_Z); bf16_t* Y = WSP(bf16_t, WS_Y); const bf16_t* SS = WSP(bf16_t, WS_SST);
    const int h = F.tid >> 7, i = F.tid & 127, tok = n * 128 + i;
    const float lf = F.in[19][l * 4 + h] * 1.4426950408889634f, lb = F.in[20][l * 4 + h] * 1.4426950408889634f;
    float q[32], o[64];
#pragma unroll
    for (int c = 0; c < 4; ++c) { const u32x4 a = *(const u32x4*)(Z + (size_t)tok * ZLD + ZC_RQ + h * 32 + c * 8);
        q[c * 8 + 0] = bflo(a.x); q[c * 8 + 1] = bfhi(a.x); q[c * 8 + 2] = bflo(a.y); q[c * 8 + 3] = bfhi(a.y); q[c * 8 + 4] = bflo(a.z); q[c * 8 + 5] = bfhi(a.z); q[c * 8 + 6] = bflo(a.w); q[c * 8 + 7] = bfhi(a.w); }
#pragma unroll
    for (int e = 0; e < 64; ++e) o[e] = 0.f;
    for (int j = 0; j < 128; ++j) {
        const bf16_t* kr = Z + (size_t)(n * 128 + j) * ZLD + ZC_RK + h * 32; const bf16_t* vr = Z + (size_t)(n * 128 + j) * ZLD + ZC_RV + h * 64;
        float s = 0.f;
#pragma unroll
        for (int c = 0; c < 4; ++c) { const u32x4 a = *(const u32x4*)(kr + c * 8);
            s += q[c * 8 + 0] * bflo(a.x) + q[c * 8 + 1] * bfhi(a.x) + q[c * 8 + 2] * bflo(a.y) + q[c * 8 + 3] * bfhi(a.y) + q[c * 8 + 4] * bflo(a.z) + q[c * 8 + 5] * bfhi(a.z) + q[c * 8 + 6] * bflo(a.w) + q[c * 8 + 7] * bfhi(a.w); }
        const float fac = (i > j) ? __builtin_amdgcn_exp2f((float)(i - j) * lf) : (i < j) ? __builtin_amdgcn_exp2f((float)(j - i) * lb) : 2.f;
        s *= fac;
#pragma unroll
        for (int c = 0; c < 8; ++c) { const u32x4 a = *(const u32x4*)(vr + c * 8);
            o[c * 8 + 0] += s * bflo(a.x); o[c * 8 + 1] += s * bfhi(a.x); o[c * 8 + 2] += s * bflo(a.y); o[c * 8 + 3] += s * bfhi(a.y); o[c * 8 + 4] += s * bflo(a.z); o[c * 8 + 5] += s * bfhi(a.z); o[c * 8 + 6] += s * bflo(a.w); o[c * 8 + 7] += s * bfhi(a.w); }
    }
    const float qf = __builtin_amdgcn_exp2f((float)(i + 1) * lf), qb = __builtin_amdgcn_exp2f((float)(128 - i) * lb);
    {
        LAS float* Sl = (LAS float*)F.lds;
        __syncthreads();
        for (int idx = F.tid; idx < 16384; idx += NTHR) { const int hh = idx >> 12, dir = (idx >> 11) & 1, e = (idx >> 5) & 63, d = idx & 31;
            Sl[(hh * 2 + dir) * 2048 + d * 64 + e] = bf2f(SS[(((size_t)dir * NCH + n) * 4 + hh) * 2048 + e * 32 + d]); }
        __syncthreads();
        const bf16_t* qrow = Z + (size_t)tok * ZLD + ZC_RQ + h * 32;
        for (int d = 0; d < 32; ++d) {
            const float qd = bf2f(qrow[d]), a = qd * qf, b = qd * qb;
            const LAS float* sf = Sl + (h * 2 + 0) * 2048 + d * 64; const LAS float* sb = Sl + (h * 2 + 1) * 2048 + d * 64;
#pragma unroll
            for (int e = 0; e < 64; ++e) o[e] += a * sf[e] + b * sb[e];
        }
    }
    float mean = 0.f;
#pragma unroll
    for (int e = 0; e < 64; ++e) mean += o[e];
    mean *= (1.f / 64.f); float var = 0.f;
#pragma unroll
    for (int e = 0; e < 64; ++e) { o[e] -= mean; var += o[e] * o[e]; }
    const float rstd = __builtin_amdgcn_rsqf(var * (1.f / 64.f) + EPS);
#pragma unroll
    for (int c = 0; c < 8; ++c) { const u32x4 g = *(const u32x4*)(Z + (size_t)tok * ZLD + ZC_RG + h * 64 + c * 8);
        u32x4 w; w.x = cvtpk(siluf_(bflo(g.x)) * o[c * 8 + 0] * rstd, siluf_(bfhi(g.x)) * o[c * 8 + 1] * rstd); w.y = cvtpk(siluf_(bflo(g.y)) * o[c * 8 + 2] * rstd, siluf_(bfhi(g.y)) * o[c * 8 + 3] * rstd);
        w.z = cvtpk(siluf_(bflo(g.z)) * o[c * 8 + 4] * rstd, siluf_(bfhi(g.z)) * o[c * 8 + 5] * rstd); w.w = cvtpk(siluf_(bflo(g.w)) * o[c * 8 + 6] * rstd, siluf_(bfhi(g.w)) * o[c * 8 + 7] * rstd);
        *(u32x4*)(Y + (size_t)tok * D + 768 + h * 64 + c * 8) = w; }
}

__device__ __forceinline__ int deal_item(int k, int bid, int G, int n, int skip) {
    const int full = n / G, rem = n - full * G;
    if (k < full) return k * G + bid;
    if (k == full) { const int j = G - 1 - skip - bid; if (j >= 0 && j < rem) return full * G + j; }
    return -1;
}
constexpr int LDS_BYTES = 147456;
constexpr int NPL = 6, LASTP = 1 + 2 * NPL, NPHASE = LASTP + 1;
#ifndef DUP_PART
#define DUP_PART 0
#endif
#ifndef DUP_KIND
#define DUP_KIND -1
#endif
__global__ void __launch_bounds__(NTHR, 2) mk_fwd(Args args) {
    extern __shared__ __attribute__((aligned(16))) unsigned char lds_raw[];
    Frame F;
    F.lds = (LAS unsigned char*)lds_raw;
    const int wave_s = __builtin_amdgcn_readfirstlane(threadIdx.x >> 6);
    const int lo = args.ph_lo, hi = args.ph_hi;
#if MK_ONE_LAUNCH
    cg::grid_group grid = cg::this_grid();
    volatile LAS unsigned* bst = (volatile LAS unsigned*)(F.lds + LDS_BYTES - 16);
    unsigned* gbar = (unsigned*)(args.ws + WS_CTL) + CW_BAR;
    if (threadIdx.x == 0) { bst[0] = 0u; bst[1] = 0u; (void)xb_add(&gbar[XB_XCNT(xb_xcc_id())], 1u); }
    __syncthreads();
#endif
#ifndef SKIPMASK
#define SKIPMASK 0
#endif
#define EN(j) (!((SKIPMASK >> (j)) & 1))
    for (int ph = lo; ph < hi; ++ph) {
        { int z_; asm volatile("s_mov_b32 %0, 0" : "=s"(z_)); F.in = args.in + z_; F.out = args.out + z_; F.ws = args.ws + z_;
          F.wave = wave_s + z_; F.G = (int)gridDim.x + z_; F.bid = (int)blockIdx.x + z_; F.NGW = F.G * NWAVES; F.gw = F.bid * NWAVES + F.wave; }
#define FRESH() do { int l_; asm volatile("v_mbcnt_lo_u32_b32 %0, -1, 0\n\tv_mbcnt_hi_u32_b32 %0, -1, %0" : "=v"(l_)); F.lane = l_; F.tid = F.wave * 64 + l_; } while (0)
#ifndef DUP_KIND
#define DUP_KIND -1
#endif
#define KIND_OF(idx_) ((idx_) + ((idx_) >= 3 ? 1 : 0) + ((idx_) >= 5 ? 3 : 0))
#define POS_OF(k_) ((k_) - ((k_) > 3 ? 1 : 0) - ((k_) > 8 ? 1 : 0))
        int po = ph;
        if (DUP_KIND == 20) { po = ph > 0 ? ph - 1 : 0; }
        else if (DUP_KIND == 21) { po = ph > LASTP ? LASTP : ph; }
        else if (DUP_KIND >= 0) { if (po > 1 + NPL + POS_OF(DUP_KIND) + 1) po -= 2; else if (po > 1 + POS_OF(DUP_KIND)) po -= 1; }
#if DUP_KIND >= 0
        const bool isdup = (DUP_KIND == 21) ? (ph == LASTP + 1) : (DUP_KIND == 20) ? false : (ph == 1 + POS_OF(DUP_KIND) + 1 || ph == 1 + NPL + POS_OF(DUP_KIND) + 2);
#else
        constexpr bool isdup = false;
#endif
        const int pos_ = __builtin_amdgcn_readfirstlane(po);
        int l = __builtin_amdgcn_readfirstlane((pos_ >= 1 + NPL) ? 1 : 0); asm volatile("" : "+s"(l));
        int kind = __builtin_amdgcn_readfirstlane((pos_ == 0) ? -1 : (pos_ == LASTP) ? 11 : KIND_OF(pos_ - 1 - NPL * l)); asm volatile("" : "+s"(kind));
        const float lam_init = (l == 0) ? 0.2f : (0.8f - 0.6f * 0.7408182206817179f);
        const bool last = (l == 1);
        const float* modv = WSP(float, WS_MODV) + (size_t)l * 2 * 6144;
        if (kind == -1) { FRESH(); mod_items(F); rope_table(F); wabsmax_items(F, 0, 1); }
        else if (kind == 0 && EN(0)) { FRESH(); norm1_phase(F, l, isdup); convert_weights(F, l, 0); }
        else if (kind == 1 && EN(1)) {
            FRESH();
            {
                pg8::Gemm g{(const bf16_t*)WSP(unsigned char, WS_H8), WSP(bf16_t, WS_WIN), D / 2, D / 2, D / 2};
                pg8::DenseOrder S{MT / 256, NIN / 256, F.G, F.bid, D / 2, D / 2};
                pg8::EpiInI8 E{pg8::EpiIn{WSP(bf16_t, WS_Z), WSP(bf16_t, WS_G), F.in[22] + (size_t)l * GLD, WSP(float, WS_ROPE)}, WSP(float, WS_HS), WSP(unsigned, WS_CTL) + CW_WMAX + l * 64};
                pg8::gemm_phase(F.lds, F.tid, g, S, E);
            }
            if (l == 0) { FRESH(); w13absmax_items(F, 0); }
        }
        else if (kind == 2 && EN(2)) {
            FRESH();
            const bool cvt_first = ((F.bid >> 3) & 1) != 0;
#pragma unroll 1
            for (int pass = 0; pass < 2; ++pass) {
                if ((pass == 0) == cvt_first) { if (!isdup) convert_weights(F, l, 1); }
                else {
                    if (!isdup || DUP_PART == 0 || DUP_PART == 1) for (int k = 0, t; (t = deal_item(k, F.bid, F.G, last ? 256 : 260, 0)) >= 0; ++k) conv_a_tile(F, l, t);
                    if (!isdup || DUP_PART == 0 || DUP_PART == 2) { conv_b_items(F, l); kmax_items(F, l); }
                    if (!isdup || DUP_PART == 0 || DUP_PART == 3) for (int k = 0, u; (u = deal_item(k, F.bid, F.G, NCH * 4, last ? 0 : 4)) >= 0; ++k) ret_kv_unit(F, l, u);
                }
                __syncthreads();
            }
        }
        else if (kind == 4 && EN(4)) {
            FRESH();
            const float lam = 0.f;
            const int nitems = last ? 256 : 260;
            if (!isdup) scan_publish(F, l);
#if MK_NAIVE_ATTN
            for (int it = F.bid; it < nitems; it += F.G) naive_attn_item(F, l, it, lam, lam_init);
#else
            if (!isdup || DUP_PART != 2) for (int u = F.bid; u < nitems; u += F.G) {
                if (u < 256) att::attn_unit2(F, l, (u & 7) >> 1, ((u >> 3) * 2 + (u & 1)) * 256, 0, MT / 64, lam, lam_init, isdup);
                else att::attn_unit2(F, l, u - 256, SEQ, SEQ, CTXL / 64, lam, lam_init, isdup);
            }
            __syncthreads();
#endif
#if MK_NAIVE_RET
            if (!isdup || DUP_PART != 1) for (int n = F.bid; n < (last ? 128 : NCH); n += F.G) naive_ret_item(F, l, n);
#else
            scan_wait(F, l);
            if (!isdup || DUP_PART != 1) for (int k = 0, u; (u = deal_item(k, F.bid, F.G, last ? 256 : 2 * NCH, 0)) >= 0; ++k) att::ret_unit(F, l, u >> 1, u & 1);
            __syncthreads();
#endif
        }
        else if (kind == 5 && EN(5)) {
            FRESH();
            unsigned* mcnt = WSP(unsigned, WS_CTL) + CW_MDONE + l * 80 * 64;
            unsigned* wcnt = WSP(unsigned, WS_CTL) + CW_WODONE + l * 80 * 64;
            {
                pg8::Gemm g{WSP(bf16_t, WS_Y), WSP(bf16_t, WS_WB), D, 256, 256};
                pg8::MergeOrder S{mcnt, last ? SEQ / 256 : MT / 256, F.G, F.bid};
                pg8::EpiMerge E{WSP(bf16_t, WS_G), WSP(bf16_t, WS_H)};
                pg8::gemm_phase(F.lds, F.tid, g, S, E);
            }
            {
                pg8::Gemm g{WSP(bf16_t, WS_H), WSP(bf16_t, WS_WO), D, D, D};
                pg8::WoOrder S{last ? SEQ / 256 : MT / 256, F.G, F.bid, mcnt, wcnt};
                pg8::EpiWo E{l == 0 ? F.in[0] : F.out, F.out, F.in[2], WSP(float, WS_XC), modv + 2 * D, modv + 6144 + 2 * D};
                pg8::gemm_phase(F.lds, F.tid, g, S, E);
            }
            FRESH();
            route_phase(F, l, isdup, wcnt);
            if (!isdup) convert_weights(F, l, 2);
            if (!last) {
                const bool sub = F.G > 20;
                if (!sub || (F.bid >= 16 && F.bid < F.G - 4)) {
                    FRESH();
                    const int Gs = F.G, bs = F.bid;
                    if (sub) { F.G = Gs - 20; F.bid = bs - 16; }
                    w13absmax_items(F, 1); wabsmax_items(F, 1, 2);
                    F.G = Gs; F.bid = bs;
                }
            }
        }
        else if (kind == 9 && EN(9)) {
            FRESH();
            LAS int* tbl = (LAS int*)(F.lds + 131072);
            const int nblk = pg8::moe_table(tbl, WSP(unsigned, WS_CTL) + CW_CNT + l * 2048, F.tid);
            if (F.bid == 0 && F.tid < NE) WSP(int, WS_META)[256 + F.tid] = tbl[160 + F.tid];
            unsigned* dcnt = WSP(unsigned, WS_CTL) + CW_E1DONE + l * 160 * 64;
            {
                pg8::Gemm g{(const bf16_t*)WSP(unsigned char, WS_H2I), WSP(bf16_t, WS_W13), D / 2, D / 2, D / 2};
                pg8::MoeOrderT<true> S{tbl, nblk * 4, F.G, F.bid, D / 2, D / 2, WSP(unsigned short, WS_INV), dcnt};
                pg8::EpiE1I8 E{pg8::EpiE1{WSP(bf16_t, WS_G + (size_t)CAP * D * 2)}, WSP(float, WS_HSS), WSP(unsigned, WS_CTL) + CW_WMAX13 + l * 64, tbl};
                pg8::gemm_phase(F.lds, F.tid, g, S, E);
            }
            {
                pg8::Gemm g{WSP(bf16_t, WS_G + (size_t)CAP * D * 2), WSP(bf16_t, WS_W2), FFE / 2, FFE / 2, FFE / 2};
                pg8::MoeOrderE2H S{tbl, nblk, F.G, F.bid, FFE / 2, FFE / 2, dcnt};
                pg8::EpiE2H8 E{WSP(bf16_t, WS_Z)};
                pg8::gemm_phase(F.lds, F.tid, g, S, E);
            }
        }
        else if (kind == 11) { FRESH(); final_phase(F, isdup); }
#if MK_ONE_LAUNCH
        if (ph + 1 < hi) { if (ph == lo) grid.sync(); else { FRESH(); xcd_barrier(gbar, bst, F.tid, (unsigned)F.G); } }
#endif
    }
}

extern "C" void kernel_launch(void* const* d_in, const int* in_sizes, int n_in, void* d_out, int out_size, void* d_ws, size_t ws_size, hipStream_t stream) {
    static int grid = 0;
    if (grid == 0) {
        if (n_in != 31 || out_size != SEQ * D || ws_size < WS_END) { fprintf(stderr, "kernel_launch: unexpected sizes n_in %d out %d ws %zu (need %zu)\n", n_in, out_size, ws_size, (size_t)WS_END); grid = -1; return; }
        int dev = 0, cus = 0, per_cu = 0;
        (void)hipGetDevice(&dev); (void)hipDeviceGetAttribute(&cus, hipDeviceAttributeMultiprocessorCount, dev);
        (void)hipFuncSetAttribute((const void*)mk_fwd, hipFuncAttributeMaxDynamicSharedMemorySize, LDS_BYTES);
        (void)hipOccupancyMaxActiveBlocksPerMultiprocessor(&per_cu, (const void*)mk_fwd, NTHR, LDS_BYTES);
        if (per_cu < 1) { fprintf(stderr, "kernel_launch: occupancy query says %d blocks/CU\n", per_cu); per_cu = 1; }
        grid = cus;
        (void)hipGetLastError();
    }
    if (grid < 0) return;
    (void)hipMemsetAsync((char*)d_ws + WS_CTL, 0, CTL_ZERO_BYTES, stream);
    Args a{};
    for (int i = 0; i < 31; ++i) a.in[i] = (const float*)d_in[i];
    a.out = (float*)d_out; a.ws = (unsigned char*)d_ws;
#if MK_ONE_LAUNCH
    a.ph_lo = 0; a.ph_hi = NPHASE + (DUP_KIND >= 20 ? 1 : DUP_KIND >= 0 ? 2 : 0);
    void* kargs[] = {&a};
    hipError_t e = hipLaunchCooperativeKernel((const void*)mk_fwd, dim3(grid), dim3(NTHR), kargs, LDS_BYTES, stream);
    if (e != hipSuccess) fprintf(stderr, "cooperative launch failed: %s (grid %d)\n", hipGetErrorString(e), grid);
#else
    for (int p = 0; p < NPHASE; ++p) { a.ph_lo = p; a.ph_hi = p + 1; hipLaunchKernelGGL(mk_fwd, dim3(grid), dim3(NTHR), LDS_BYTES, stream, a); }
#endif
}
```
